# Optimizing an MI355X kernel written in HIP

```python
import math
import jax, jax.numpy as jnp
from jax import lax
import numpy as np

D_MODEL = 4096
BATCH = 8
SEQ = 2048
DEPTH = 2

HEAD_DIM = 128
A_HEADS = (3 * D_MODEL) // (8 * HEAD_DIM)
A_KV_HEADS = A_HEADS // 3
A_GROUP = A_HEADS // A_KV_HEADS
A_WINDOW = 128
A_BLOCK = 128
POOL_GROUPS = 4
POOL_WIDTH = D_MODEL // 4
POOL_GROUP_WIDTH = POOL_WIDTH // POOL_GROUPS
POOL_WINDOWS = (2, 4, 8, 16)
C_HEADS = (3 * D_MODEL) // (8 * HEAD_DIM)
C_HALF_DIM = HEAD_DIM // 2
C_Q_BLOCK = 128
A_Q_W = A_HEADS * HEAD_DIM
A_KV_W = A_KV_HEADS * HEAD_DIM
C_W = C_HEADS * HEAD_DIM
MIX_WIDTH = A_Q_W + POOL_WIDTH + C_W
IN_SIZES = (A_Q_W, A_KV_W, A_KV_W, POOL_WIDTH, C_W, C_W, C_W)
IN_WIDTH = sum(IN_SIZES)
IN_SPLITS = tuple(int(s) for s in np.cumsum(IN_SIZES)[:-1])
BRANCH_SPLITS = (A_Q_W, A_Q_W + POOL_WIDTH)
N_BRANCHES = 3
ADA_CHUNKS = 6
FFN_HIDDEN = -(-8 * D_MODEL // (3 * 256)) * 256
NEG_INF = -1e30
NORM_EPS = 1e-6
SUBLN_EPS = 1e-5

kernel_name = "hybrid_parallel_gated_encoder"


def rms_norm(x, g, eps=NORM_EPS):
    xf = x.astype(jnp.float32)
    y = xf * lax.rsqrt(jnp.mean(xf * xf, axis=-1, keepdims=True) + eps)
    return (y * g.astype(jnp.float32)).astype(x.dtype)


def modulate(h, shift, scale):
    return h * (1 + scale[:, None, :]) + shift[:, None, :]


def alibi_slopes(n):
    return jnp.asarray(2.0 ** (-8.0 * np.arange(1, n + 1) / n), dtype=jnp.float32)


def windowed_gqa_sink(q, k, v, sink):
    B, T = q.shape[0], q.shape[1]
    nb = T // A_BLOCK
    qb = q.reshape(B, nb, A_BLOCK, A_KV_HEADS, A_GROUP, HEAD_DIM)
    pad = ((0, 0), (A_BLOCK, A_BLOCK), (0, 0), (0, 0))
    kp = jnp.pad(k, pad).reshape(B, nb + 2, A_BLOCK, A_KV_HEADS, HEAD_DIM)
    vp = jnp.pad(v, pad).reshape(B, nb + 2, A_BLOCK, A_KV_HEADS, HEAD_DIM)
    kb = jnp.concatenate([kp[:, :-2], kp[:, 1:-1], kp[:, 2:]], axis=2)
    vb = jnp.concatenate([vp[:, :-2], vp[:, 1:-1], vp[:, 2:]], axis=2)
    logits = jnp.einsum('bnqhgd,bnshd->bnhgqs', qb, kb,
                        preferred_element_type=jnp.float32) * (HEAD_DIM ** -0.5)
    qi = jnp.arange(A_BLOCK)
    kj = jnp.arange(3 * A_BLOCK)
    rel = qi[:, None] + A_BLOCK - kj[None, :]
    kpos = jnp.arange(nb)[:, None] * A_BLOCK - A_BLOCK + kj[None, :]
    mask = (jnp.abs(rel) <= A_WINDOW)[None] & ((kpos >= 0) & (kpos < T))[:, None, :]
    slopes = alibi_slopes(A_HEADS).reshape(A_KV_HEADS, A_GROUP)
    bias = -slopes[:, :, None, None] * jnp.abs(rel).astype(jnp.float32)
    logits = jnp.where(mask[None, :, None, None], logits + bias, NEG_INF)
    s = sink.astype(jnp.float32).reshape(A_KV_HEADS, A_GROUP)[None, None, :, :, None, None]
    m = jnp.maximum(jnp.max(logits, axis=-1, keepdims=True), s)
    p = jnp.exp(logits - m)
    probs = p / (jnp.sum(p, axis=-1, keepdims=True) + jnp.exp(s - m))
    o = jnp.einsum('bnhgqs,bnshd->bnqhgd', probs.astype(v.dtype), vb)
    return o.reshape(B, T, A_Q_W)


def multiscale_pool(u, pool_w, pool_scale):
    B, T = u.shape[0], u.shape[1]
    ug = u.reshape(B, T, POOL_GROUPS, POOL_GROUP_WIDTH).astype(jnp.float32)
    csum = jnp.pad(jnp.cumsum(ug, axis=1), ((0, 0), (1, 0), (0, 0), (0, 0)))
    pos = jnp.arange(T)
    means = []
    for g, w in enumerate(POOL_WINDOWS):
        r = w // 2
        lo = jnp.maximum(pos - r, 0)
        hi = jnp.minimum(pos + r + 1, T)
        sg = csum[:, :, g]
        cnt = (hi - lo).astype(jnp.float32)[None, :, None]
        means.append((sg[:, hi] - sg[:, lo]) / cnt)
    pooled = jnp.stack(means, axis=2)
    z = (pooled - ug).astype(u.dtype)
    z = jnp.einsum('btgc,gcd->btgd', z, pool_w)
    return z.reshape(B, T, POOL_WIDTH) * pool_scale


def diff_attention(q, k, v, lam, subln_g, lam_init):
    B, T = q.shape[0], q.shape[1]
    nb = T // C_Q_BLOCK
    qb = q.reshape(B, nb, C_Q_BLOCK, C_HEADS, 2, C_HALF_DIM).transpose(1, 0, 2, 3, 4, 5)
    slopes = alibi_slopes(C_HEADS)[:, None, None, None]
    kpos = jnp.arange(T)
    scale = C_HALF_DIM ** -0.5

    def block(args):
        qblk, n = args
        logits = jnp.einsum('bqhcd,bshcd->bhcqs', qblk, k,
                            preferred_element_type=jnp.float32) * scale
        qpos = n * C_Q_BLOCK + jnp.arange(C_Q_BLOCK)
        dist = jnp.abs(qpos[:, None] - kpos[None, :]).astype(jnp.float32)
        probs = jax.nn.softmax(logits - slopes * dist, axis=-1)
        wts = probs[:, :, 0] - lam * probs[:, :, 1]
        return jnp.einsum('bhqs,bshd->bqhd', wts.astype(v.dtype), v)

    o = lax.map(block, (qb, jnp.arange(nb)))
    o = o.transpose(1, 0, 2, 3, 4).reshape(B, T, C_HEADS, HEAD_DIM)
    o = rms_norm(o, subln_g, eps=SUBLN_EPS) * (1 - lam_init)
    return o.reshape(B, T, C_W)


def hybrid_mixer(h, w_in, sink, pool_w, pool_scale, lam_vecs, subln_g,
                 w_gate, b_gate, w_branch, w_out, lam_init):
    B, T = h.shape[0], h.shape[1]
    proj = jnp.einsum('btd,de->bte', h, w_in)
    qa, ka, va, u, qc, kc, vc = jnp.split(proj, IN_SPLITS, axis=-1)
    oa = windowed_gqa_sink(qa.reshape(B, T, A_HEADS, HEAD_DIM),
                           ka.reshape(B, T, A_KV_HEADS, HEAD_DIM),
                           va.reshape(B, T, A_KV_HEADS, HEAD_DIM), sink)
    ob = multiscale_pool(u, pool_w, pool_scale)
    lv = lam_vecs.astype(jnp.float32)
    lam = jnp.exp(jnp.sum(lv[0] * lv[1])) - jnp.exp(jnp.sum(lv[2] * lv[3])) + lam_init
    oc = diff_attention(qc.reshape(B, T, C_HEADS, 2, C_HALF_DIM),
                        kc.reshape(B, T, C_HEADS, 2, C_HALF_DIM),
                        vc.reshape(B, T, C_HEADS, HEAD_DIM), lam, subln_g, lam_init)
    gates = jax.nn.sigmoid(jnp.einsum('btd,de->bte', h, w_gate) + b_gate)
    gates = gates.reshape(B, T, N_BRANCHES, D_MODEL)
    wa, wb, wc = jnp.split(w_branch, BRANCH_SPLITS, axis=0)
    merged = (gates[:, :, 0] * jnp.einsum('btk,kd->btd', oa, wa)
              + gates[:, :, 1] * jnp.einsum('btk,kd->btd', ob, wb)
              + gates[:, :, 2] * jnp.einsum('btk,kd->btd', oc, wc))
    return jnp.einsum('btd,de->bte', merged, w_out)


def swiglu(h, w_gate, w_up, w_down):
    a = jnp.einsum('btd,df->btf', h, w_gate)
    b = jnp.einsum('btd,df->btf', h, w_up)
    return jnp.einsum('btf,fd->btd', jax.nn.silu(a) * b, w_down)


def setup_inputs(seed: int = 0) -> dict:
    key = jax.random.key(seed)
    ks = jax.random.split(key, 21)
    D = D_MODEL

    def nrm(k, shape, scale):
        return jax.random.normal(k, shape, jnp.float32) * scale

    return {
        'x': nrm(ks[0], (BATCH, SEQ, D), 1.0),
        'c': nrm(ks[1], (BATCH, D), 1.0),
        'ada_w': nrm(ks[2], (DEPTH, D, ADA_CHUNKS * D), 0.5 * D ** -0.5),
        'ada_b': nrm(ks[3], (DEPTH, ADA_CHUNKS * D), 0.02),
        'mix_pre_g': 1.0 + nrm(ks[4], (DEPTH, D), 0.05),
        'mix_post_g': 1.0 + nrm(ks[5], (DEPTH, D), 0.05),
        'w_in': nrm(ks[6], (DEPTH, D, IN_WIDTH), D ** -0.5),
        'attn_sink': nrm(ks[7], (DEPTH, A_HEADS), 0.5),
        'pool_w': nrm(ks[8], (DEPTH, POOL_GROUPS, POOL_GROUP_WIDTH, POOL_GROUP_WIDTH), POOL_GROUP_WIDTH ** -0.5),
        'pool_scale': 1.0 + nrm(ks[9], (DEPTH, POOL_WIDTH), 0.1),
        'diff_lambda': nrm(ks[10], (DEPTH, 4, C_HALF_DIM), 0.1),
        'diff_subln_g': 1.0 + nrm(ks[11], (DEPTH, HEAD_DIM), 0.05),
        'w_gate': nrm(ks[12], (DEPTH, D, N_BRANCHES * D), D ** -0.5),
        'b_gate': nrm(ks[13], (DEPTH, N_BRANCHES * D), 0.02),
        'w_branch': nrm(ks[14], (DEPTH, MIX_WIDTH, D), C_W ** -0.5),
        'w_out': nrm(ks[15], (DEPTH, D, D), D ** -0.5),
        'ffn_pre_g': 1.0 + nrm(ks[16], (DEPTH, D), 0.05),
        'ffn_post_g': 1.0 + nrm(ks[17], (DEPTH, D), 0.05),
        'ffn_w_gate': nrm(ks[18], (DEPTH, D, FFN_HIDDEN), D ** -0.5),
        'ffn_w_up': nrm(ks[19], (DEPTH, D, FFN_HIDDEN), D ** -0.5),
        'ffn_w_down': nrm(ks[20], (DEPTH, FFN_HIDDEN, D), FFN_HIDDEN ** -0.5),
    }


def reference(x, c, ada_w, ada_b, mix_pre_g, mix_post_g, w_in, attn_sink, pool_w,
              pool_scale, diff_lambda, diff_subln_g, w_gate, b_gate, w_branch, w_out,
              ffn_pre_g, ffn_post_g, ffn_w_gate, ffn_w_up, ffn_w_down):
    cond = jax.nn.silu(c)
    for l in range(DEPTH):
        lam_init = 0.8 - 0.6 * math.exp(-0.3 * l)
        mod = jnp.einsum('bd,de->be', cond, ada_w[l]) + ada_b[l]
        shift1, scale1, gate1, shift2, scale2, gate2 = jnp.split(mod, ADA_CHUNKS, axis=-1)
        h = modulate(rms_norm(x, mix_pre_g[l]), shift1, scale1)
        y = hybrid_mixer(h, w_in[l], attn_sink[l], pool_w[l], pool_scale[l], diff_lambda[l],
                         diff_subln_g[l], w_gate[l], b_gate[l], w_branch[l], w_out[l], lam_init)
        x = x + gate1[:, None, :] * rms_norm(y, mix_post_g[l])
        h = modulate(rms_norm(x, ffn_pre_g[l]), shift2, scale2)
        y = swiglu(h, ffn_w_gate[l], ffn_w_up[l], ffn_w_down[l])
        x = x + gate2[:, None, :] * rms_norm(y, ffn_post_g[l])
    return x
```

```cpp
#include <hip/hip_runtime.h>
#include <cstdio>
#include <cstdint>

#ifndef MK_N_LAUNCHES
#define MK_N_LAUNCHES 1
#endif

#define LAS __attribute__((address_space(3)))
#define GAS __attribute__((address_space(1)))
typedef unsigned short bf16_t;
typedef short bf16x8 __attribute__((ext_vector_type(8)));
typedef short s16x4 __attribute__((ext_vector_type(4)));
typedef float f32x4 __attribute__((ext_vector_type(4)));
typedef float f32x2 __attribute__((ext_vector_type(2)));
typedef unsigned u32x4 __attribute__((ext_vector_type(4)));
typedef unsigned u32x2 __attribute__((ext_vector_type(2)));
typedef GAS bf16_t gbf;
typedef GAS float gfl;
typedef GAS unsigned char guc;

constexpr int D = 4096, BATCH = 8, T = 2048, DEPTH = 2, M = BATCH * T;
constexpr int IN_W = 8192, GATE_W = 12288, N1 = IN_W + GATE_W;
constexpr int FF = 11008, NF = 2 * FF;
constexpr int ADA = 6 * D;
constexpr int OFF_QA = 0, OFF_KA = 1536, OFF_VA = 2048, OFF_U = 2560, OFF_QC = 3584, OFF_KC = 5120, OFF_VC = 6656;
constexpr int MIX_B = 1536, MIX_C = 2560;
constexpr int POOLW = 1024;
constexpr float NORM_EPS = 1e-6f, SUBLN_EPS = 1e-5f;
constexpr float LOG2E = 1.4426950408889634f;

constexpr size_t MiB = 1u << 20;
constexpr size_t WS_CTL = 0, CTL_ZERO_BYTES = 1 * MiB;
constexpr size_t WS_MOD = 1 * MiB;
constexpr size_t WS_PWT = 3 * MiB;
constexpr size_t WS_W = 4 * MiB, W_LAYER = 482 * MiB;
constexpr size_t W_1 = 0, W_B = 160 * MiB, W_O = 192 * MiB, W_F = 224 * MiB, W_D = 396 * MiB;
constexpr size_t WS_H = 968 * MiB, WS_MIX = 1096 * MiB, WS_MERG = 1224 * MiB, WS_Y = 1352 * MiB, WS_M32 = 1480 * MiB, WS_Z = 1736 * MiB;
constexpr size_t WS_PROJ = 1768 * MiB, WS_GATES = 2024 * MiB, WS_HID = WS_PROJ, WS_END = 2408 * MiB;
static_assert(WS_W + 2 * W_LAYER == WS_H, "ws map");
static_assert((size_t)M * FF * 2 <= WS_END - WS_HID, "hid overlay");
constexpr int CW_TMO = 0, CW_BAR = 4096, CW_NMAX = 32768;

constexpr int RING_BYTES = 131072;
constexpr int LDSCTL_OFF = RING_BYTES, MISC_OFF = LDSCTL_OFF + 320;
constexpr int LDS_BYTES = 147456;

#define LDS_WAIT() asm volatile("s_waitcnt lgkmcnt(0)" ::: "memory")
#define VM_WAIT() asm volatile("s_waitcnt vmcnt(0)" ::: "memory")

typedef float f32x2_t __attribute__((ext_vector_type(2))); typedef __bf16 bf16x2_t __attribute__((ext_vector_type(2)));
__device__ __forceinline__ unsigned cvt_pk_bf16(float lo, float hi) { f32x2_t v = {lo, hi}; bf16x2_t b = __builtin_convertvector(v, bf16x2_t); return __builtin_bit_cast(unsigned, b); }
__device__ __forceinline__ float bf_lo(unsigned w) { return __uint_as_float(w << 16); }
__device__ __forceinline__ float bf_hi(unsigned w) { return __uint_as_float(w & 0xffff0000u); }
__device__ __forceinline__ float wave_sum(float v) {
#pragma unroll
    for (int o = 1; o < 64; o <<= 1) v += __shfl_xor(v, o);
    return v;
}
__device__ __forceinline__ int opq(int k) { asm volatile("" : "+s"(k)); return k; }
template <class TP> __device__ __forceinline__ TP* opqp(TP* p) { asm volatile("" : "+s"(p)); return p; }
__device__ __forceinline__ int fresh_tid() { int t = threadIdx.x; asm volatile("" : "+v"(t)); return t; }
__device__ __forceinline__ float fast_sigmoid(float x) { return __builtin_amdgcn_rcpf(1.0f + __builtin_amdgcn_exp2f(-x * LOG2E)); }

#define XB_TMO      128
#define XB_XCNT(j)  (256  + 64 * (j))
#define XB_XSUB(j)  (1280 + 64 * (j))
#define XB_XGEN(j)  (2304 + 64 * (j))
#define XB_TOP      3328
#define XB_TOPGEN   3392
#define XCD_BAR_WORDS 3456
#define XB_SPIN_CAP (1u << 18)
__device__ __forceinline__ unsigned xb_ld(unsigned* p)              { return __hip_atomic_load(p, __ATOMIC_RELAXED, __HIP_MEMORY_SCOPE_AGENT); }
__device__ __forceinline__ unsigned xb_add(unsigned* p, unsigned v) { return __hip_atomic_fetch_add(p, v, __ATOMIC_RELAXED, __HIP_MEMORY_SCOPE_AGENT); }
__device__ __forceinline__ unsigned xb_xcc_id() { return (unsigned)__builtin_amdgcn_s_getreg((3 << 11) | 20) & 0xFu; }
#define XB_SPIN(cond, bar) do { unsigned _sp = 0; while (cond) { __builtin_amdgcn_s_sleep(1); \
    if ((++_sp & 255u) == 0u) { if (xb_ld(&(bar)[XB_TMO])) break; if (_sp > XB_SPIN_CAP) { atomicAdd(&(bar)[XB_TMO], 1u); break; } } } } while (0)
struct XcdBarrier { unsigned* bar; unsigned x; volatile LAS unsigned* st; };
__device__ __forceinline__ XcdBarrier xcd_barrier_post(unsigned* bar, volatile LAS unsigned* st) {
    XcdBarrier b; b.bar = bar; b.x = xb_xcc_id(); b.st = st;
    if (threadIdx.x == 0) (void)xb_add(&bar[XB_XCNT(b.x)], 1u);
    return b;
}
__device__ __forceinline__ void xcd_barrier_complete(unsigned* bar, unsigned x, unsigned& nloc, unsigned& nx) {
    const unsigned G = gridDim.x * gridDim.y * gridDim.z;
    unsigned sum, cnt, mine, sp = 0u;
    for (;;) {
        sum = 0u; cnt = 0u; mine = 0u;
#pragma unroll
        for (unsigned j = 0; j < 16; ++j) { const unsigned c = xb_ld(&bar[XB_XCNT(j)]); sum += c; cnt += (c > 0u) ? 1u : 0u; mine = (j == x) ? c : mine; }
        if (sum == G) break;
        __builtin_amdgcn_s_sleep(1);
        if ((++sp & 255u) == 0u) { if (xb_ld(&bar[XB_TMO])) break; if (sp > XB_SPIN_CAP) { atomicAdd(&bar[XB_TMO], 1u); break; } }
    }
    nloc = mine > 0u ? mine : 1u; nx = cnt > 0u ? cnt : 1u;
}
__device__ __forceinline__ void xcd_barrier(const XcdBarrier& b) {
    asm volatile("s_waitcnt vmcnt(0)" ::: "memory");
    __syncthreads();
    if (threadIdx.x == 0) {
        unsigned* bar = b.bar;
        __builtin_amdgcn_s_waitcnt(0);
        unsigned nloc = b.st[0], nx = b.st[1];
        if (nloc == 0u) { xcd_barrier_complete(bar, b.x, nloc, nx); b.st[0] = nloc; b.st[1] = nx; }
        const unsigned old = xb_add(&bar[XB_XSUB(b.x)], 1u);
        const unsigned gen = old / nloc;
        if (old + 1u == (gen + 1u) * nloc) {
            __builtin_amdgcn_fence(__ATOMIC_RELEASE, "agent");
            asm volatile("s_waitcnt vmcnt(0)" ::: "memory");
            const unsigned og = xb_add(&bar[XB_TOP], 1u);
            const unsigned tg = og / nx;
            if (og + 1u == (tg + 1u) * nx) xb_add(&bar[XB_TOPGEN], 1u);
            else XB_SPIN(xb_ld(&bar[XB_TOPGEN]) == tg, bar);
            __builtin_amdgcn_fence(__ATOMIC_ACQUIRE, "agent");
            xb_add(&bar[XB_XGEN(b.x)], 1u);
            asm volatile("s_waitcnt vmcnt(0)" ::: "memory");
        } else {
            XB_SPIN(xb_ld(&bar[XB_XGEN(b.x)]) == gen, bar);
            __builtin_amdgcn_fence(__ATOMIC_ACQUIRE, "agent");
            asm volatile("s_waitcnt vmcnt(0)" ::: "memory");
        }
    }
    __syncthreads();
}

namespace pg8 {
constexpr int BM = 256, BK = 64, HALF = 128, HTB = HALF * BK * 2, STAGE_BYTES = 8 * HTB, NXCD = 8, WGM = 8;
__host__ __device__ __forceinline__ int lds_byte(int r, int c) { const int st = (r >> 4) * 2 + (c >> 5), rr = r & 15, cc = c & 31, ob = rr * 64 + cc * 2; return st * 1024 + (ob ^ (((ob >> 9) & 1) << 5)); }
__host__ __device__ __forceinline__ void stage_rc(int b, int& R, int& C) { const int st = b / 1024, sb = b % 1024, swz = sb ^ (((sb >> 9) & 1) << 5); R = (st >> 1) * 16 + swz / 64; C = (st & 1) * 32 + (swz % 64) / 2; }
__host__ __device__ __forceinline__ int perm32(int rho) { const int n = rho >> 4, i = rho & 15; return 8 * (i >> 2) + 4 * n + (i & 3); }

__host__ __device__ __forceinline__ size_t btile_off(int r, int kt, int c8, int nkt) {
    const int pn = r >> 8, half = (r >> 7) & 1, rl = r & 127, q = rl & 31, rho = (rl & ~31) + 16 * ((q >> 2) & 1) + 4 * (q >> 3) + (q & 3);
    return ((size_t)pn * nkt + kt) * (size_t)(2 * HTB) + (size_t)half * HTB + lds_byte(rho, 8 * c8);
}
__host__ __device__ __forceinline__ size_t atile_off(int r, int k, int nkt) {
    return ((size_t)(r >> 8) * nkt + (k >> 6)) * (size_t)(2 * HTB) + (size_t)((r >> 7) & 1) * HTB + lds_byte(r & 127, k & 56) + (k & 7) * 2;
}
struct Unit { int pm, pn, seg; };
template <int NSEG, int AK1, int AK2, int NT0, int NT1, int NT2>
struct Prob {
    const gbf* A; const gbf* B; int lda, ldb;
    int nM, nN, G, c, apn, bshare;
    __device__ __forceinline__ bool next(int i, Unit& u) const {
        const int nwg = nM * nN; if (c >= nwg) return false;
        const int nr = (nwg - c + G - 1) / G;
        int seg = 0, j = i;
        if constexpr (NSEG > 1) { j = i / NSEG; seg = i - j * NSEG; }
        if (j >= nr) return false;
        int wgid = j * G + c; { const int q = nwg / NXCD, r = nwg % NXCD, xcd = wgid % NXCD, off = wgid / NXCD; wgid = (xcd < r ? xcd * (q + 1) : r * (q + 1) + (xcd - r) * q) + off; }
        const int nig = WGM * nN, gid = wgid / nig, fm = gid * WGM, gsz = (nM - fm) < WGM ? (nM - fm) : WGM;
        u.pm = fm + ((wgid % nig) % gsz); u.pn = (wgid % nig) / gsz; u.seg = seg; return true;
    }
    __device__ __forceinline__ int nt(const Unit& u) const { if constexpr (NSEG == 1) return NT0; else return u.seg == 0 ? NT0 : (u.seg == 1 ? NT1 : NT2); }
    __device__ __forceinline__ int ak(const Unit& u) const { if constexpr (NSEG == 1) return 0; else return u.seg == 0 ? 0 : (u.seg == 1 ? AK1 : AK2); }
    __device__ __forceinline__ const GAS char* a_ptr(const Unit& u) const { return (const GAS char*)A + ((size_t)u.pm * lda + (ak(u) + u.pn * apn) / BK) * (size_t)(2 * HTB); }
    __device__ __forceinline__ const GAS char* b_ptr(const Unit& u) const { return (const GAS char*)B + ((size_t)u.pn * ldb + (bshare ? ak(u) / BK : 0)) * (size_t)(2 * HTB); }
};

template <class Epi, class ProbT, bool ALIGN_EPI, bool SP2>
__device__ __forceinline__ void gemm_phase(LAS unsigned char* lds, const ProbT& P, const Epi& E) {
    const int tid = fresh_tid(), wid = __builtin_amdgcn_readfirstlane(tid >> 6), lane = tid & 63, wr = wid >> 2, wc = wid & 3, fr = lane & 15, fq = lane >> 4;
    unsigned voffA[2], voffB[2];
#pragma unroll
    for (int i = 0; i < 2; ++i) { int R, C; stage_rc(tid * 16 + i * 8192, R, C); const int Rb = (R & ~31) + perm32(R & 31);
        voffA[i] = (unsigned)(tid * 16 + i * 8192); voffB[i] = voffA[i]; (void)Rb; (void)R; (void)C; }
    const size_t kstepB = (size_t)(2 * HTB), kstep = kstepB;
    const size_t hstepA = (size_t)HTB, hstepB = (size_t)HTB;
    const unsigned ldsw = (unsigned)wid * 1024u;
    const int aoff = lds_byte(wr * 64 + fr, fq * 8), boff = lds_byte(wc * 32 + fr, fq * 8);
#define PG8_SA(b, h) (((b) * 2 + (h)) * HTB)
#define PG8_SB(b, h) ((4 + (b) * 2 + (h)) * HTB)
#define PG8_STAGE(bufoff, gbase, voff) do { _Pragma("unroll") for (int _i = 0; _i < 2; ++_i) \
        __builtin_amdgcn_global_load_lds((const GAS unsigned*)((const GAS char*)(gbase) + (voff)[_i]), (LAS unsigned*)(lds + (bufoff) + ldsw + _i * 8192), 16, 0, 0); } while (0)
#define PG8_LDA(dst, b, h) do { _Pragma("unroll") for (int m = 0; m < 4; ++m) _Pragma("unroll") for (int k = 0; k < 2; ++k) dst[m][k] = *(const LAS bf16x8*)(lds + PG8_SA(b, h) + aoff + m * 2048 + k * 1024); } while (0)
#define PG8_LDB(dst, b, h) do { _Pragma("unroll") for (int n = 0; n < 2; ++n) _Pragma("unroll") for (int k = 0; k < 2; ++k) dst[n][k] = *(const LAS bf16x8*)(lds + PG8_SB(b, h) + boff + n * 2048 + k * 1024); } while (0)
#define PG8_MMA(ai, bj, At, Bt) do { __builtin_amdgcn_s_setprio(1); _Pragma("unroll") for (int m = 0; m < 4; ++m) _Pragma("unroll") for (int n = 0; n < 2; ++n) _Pragma("unroll") for (int k = 0; k < 2; ++k) \
        acc[ai][bj][m][n] = __builtin_amdgcn_mfma_f32_16x16x32_bf16(Bt[n][k], At[m][k], acc[ai][bj][m][n], 0, 0, 0); __builtin_amdgcn_s_setprio(0); } while (0)
#define PG8_WAIT_V(n) asm volatile("s_waitcnt vmcnt(" #n ")" ::: "memory")
#define PG8_WAIT_L(n) asm volatile("s_waitcnt lgkmcnt(" #n ")" ::: "memory")
#define PG8_BAR __builtin_amdgcn_s_barrier()
#define PG8_SCHED __builtin_amdgcn_sched_barrier(0)
    Unit cur, nxt; int ui = 0;
    if (!P.next(0, cur)) return;
    f32x4 acc[2][2][4][2];
#pragma unroll
    for (int a = 0; a < 2; ++a)
#pragma unroll
        for (int b = 0; b < 2; ++b)
#pragma unroll
            for (int m = 0; m < 4; ++m)
#pragma unroll
                for (int n = 0; n < 2; ++n) acc[a][b][m][n] = (f32x4){0.f, 0.f, 0.f, 0.f};
    bf16x8 At[4][2], B0[2][2], B1[2][2];
    const GAS char* cA = P.a_ptr(cur); const GAS char* cB = P.b_ptr(cur); int nt = P.nt(cur);
    if constexpr (SP2) {
        PG8_STAGE(PG8_SB(0, 0), cB, voffB); PG8_STAGE(PG8_SB(0, 1), cB + hstepB, voffB); PG8_STAGE(PG8_SA(0, 0), cA, voffA); PG8_STAGE(PG8_SA(0, 1), cA + hstepA, voffA);
        if (wr == 1) PG8_BAR;
        PG8_WAIT_V(2); PG8_BAR;
        PG8_STAGE(PG8_SB(1, 0), cB + kstepB, voffB); PG8_STAGE(PG8_SA(1, 0), cA + kstep, voffA); PG8_STAGE(PG8_SB(1, 1), cB + hstepB + kstepB, voffB);
        PG8_WAIT_V(6); PG8_BAR;
    } else {
        PG8_STAGE(PG8_SB(0, 0), cB, voffB); PG8_STAGE(PG8_SA(0, 0), cA, voffA); PG8_STAGE(PG8_SB(0, 1), cB + hstepB, voffB); PG8_STAGE(PG8_SA(0, 1), cA + hstepA, voffA);
        if (wr == 1) PG8_BAR;
        PG8_WAIT_V(4); PG8_BAR;
        PG8_STAGE(PG8_SB(1, 0), cB + kstepB, voffB); PG8_STAGE(PG8_SA(1, 0), cA + kstep, voffA); PG8_STAGE(PG8_SB(1, 1), cB + hstepB + kstepB, voffB);
        PG8_WAIT_V(6); PG8_BAR;
    }
    for (;;) {
        const bool has_next = P.next(ui + 1, nxt);
        const GAS char* nA = has_next ? P.a_ptr(nxt) : cA; const GAS char* nB = has_next ? P.b_ptr(nxt) : cB;
#pragma nounroll
        for (int t = 0; t < nt; t += 2) {
            const bool last = (t == nt - 2);
            const GAS char* a1 = cA + (size_t)(t + 1) * kstep;
            const GAS char* a2 = last ? nA : cA + (size_t)(t + 2) * kstep; const GAS char* b2 = last ? nB : cB + (size_t)(t + 2) * kstepB;
            const GAS char* a3 = a2 + kstep; const GAS char* b3 = b2 + kstepB;
            if constexpr (SP2) {
            PG8_LDB(B0, 0, 0); PG8_LDB(B1, 0, 1); PG8_SCHED; PG8_LDA(At, 0, 0); PG8_STAGE(PG8_SA(1, 1), a1 + hstepA, voffA);
            PG8_WAIT_V(8); PG8_WAIT_L(0); PG8_BAR; PG8_MMA(0, 0, At, B0); PG8_MMA(0, 1, At, B1); PG8_BAR; PG8_SCHED;
            PG8_LDA(At, 0, 1); PG8_STAGE(PG8_SB(0, 0), b2, voffB); PG8_STAGE(PG8_SB(0, 1), b2 + hstepB, voffB); PG8_STAGE(PG8_SA(0, 0), a2, voffA);
            PG8_WAIT_V(8); PG8_WAIT_L(0); PG8_BAR; PG8_MMA(1, 0, At, B0); PG8_MMA(1, 1, At, B1); PG8_BAR; PG8_SCHED;
            PG8_LDB(B0, 1, 0); PG8_LDB(B1, 1, 1); PG8_SCHED; PG8_LDA(At, 1, 0); PG8_STAGE(PG8_SA(0, 1), a2 + hstepA, voffA);
            PG8_WAIT_V(8); PG8_WAIT_L(0); PG8_BAR; PG8_MMA(0, 0, At, B0); PG8_MMA(0, 1, At, B1); PG8_BAR; PG8_SCHED;
            PG8_LDA(At, 1, 1); PG8_STAGE(PG8_SB(1, 0), b3, voffB); PG8_STAGE(PG8_SB(1, 1), b3 + hstepB, voffB); PG8_STAGE(PG8_SA(1, 0), a3, voffA);
            PG8_WAIT_V(8); PG8_WAIT_L(0); PG8_BAR; PG8_MMA(1, 0, At, B0); PG8_MMA(1, 1, At, B1); PG8_BAR; PG8_SCHED;
            } else {
            PG8_LDB(B0, 0, 0); PG8_SCHED; PG8_LDA(At, 0, 0); PG8_STAGE(PG8_SA(1, 1), a1 + hstepA, voffA);
            PG8_WAIT_L(8); PG8_BAR; PG8_WAIT_L(0); PG8_MMA(0, 0, At, B0); PG8_BAR; PG8_SCHED;
            PG8_LDB(B1, 0, 1); PG8_STAGE(PG8_SB(0, 0), b2, voffB);
            PG8_BAR; PG8_WAIT_L(0); PG8_MMA(0, 1, At, B1); PG8_BAR;
            PG8_LDA(At, 0, 1); PG8_STAGE(PG8_SA(0, 0), a2, voffA);
            PG8_BAR; PG8_WAIT_L(0); PG8_MMA(1, 0, At, B0); PG8_BAR; PG8_SCHED;
            PG8_STAGE(PG8_SB(0, 1), b2 + hstepB, voffB);
            PG8_WAIT_V(6); PG8_BAR; PG8_MMA(1, 1, At, B1); PG8_BAR;
            PG8_LDB(B0, 1, 0); PG8_SCHED; PG8_LDA(At, 1, 0); PG8_STAGE(PG8_SA(0, 1), a2 + hstepA, voffA);
            PG8_WAIT_L(8); PG8_BAR; PG8_WAIT_L(0); PG8_MMA(0, 0, At, B0); PG8_BAR; PG8_SCHED;
            PG8_LDB(B1, 1, 1); PG8_STAGE(PG8_SB(1, 0), b3, voffB);
            PG8_BAR; PG8_WAIT_L(0); PG8_MMA(0, 1, At, B1); PG8_BAR;
            PG8_LDA(At, 1, 1); PG8_STAGE(PG8_SA(1, 0), a3, voffA);
            PG8_BAR; PG8_WAIT_L(0); PG8_MMA(1, 0, At, B0); PG8_BAR; PG8_SCHED;
            PG8_STAGE(PG8_SB(1, 1), b3 + hstepB, voffB);
            PG8_WAIT_V(6); PG8_BAR; PG8_MMA(1, 1, At, B1); PG8_BAR;
            }
        }
        if constexpr (ALIGN_EPI) { if (wr == 0) PG8_BAR; }
        E(acc, cur, wr, wc, fr, fq);
        if (!has_next) break;
        if (!E.keep(cur)) {
#pragma unroll
        for (int a = 0; a < 2; ++a)
#pragma unroll
            for (int b = 0; b < 2; ++b)
#pragma unroll
                for (int m = 0; m < 4; ++m)
#pragma unroll
                    for (int n = 0; n < 2; ++n) acc[a][b][m][n] = (f32x4){0.f, 0.f, 0.f, 0.f};
        }
        cur = nxt; cA = nA; cB = nB; nt = P.nt(cur); ++ui;
        if constexpr (ALIGN_EPI) { if (wr == 1) PG8_BAR; }
    }
    PG8_WAIT_V(0);
    if constexpr (!ALIGN_EPI) { if (wr == 0) PG8_BAR; }
    PG8_BAR;
#undef PG8_SA
#undef PG8_SB
#undef PG8_STAGE
#undef PG8_LDA
#undef PG8_LDB
#undef PG8_MMA
#undef PG8_WAIT_V
#undef PG8_WAIT_L
#undef PG8_BAR
#undef PG8_SCHED
}

__device__ __forceinline__ u32x4 pack8(const f32x4 v0, const f32x4 v1) { u32x4 w; w.x = cvt_pk_bf16(v0[0], v0[1]); w.y = cvt_pk_bf16(v0[2], v0[3]); w.z = cvt_pk_bf16(v1[0], v1[1]); w.w = cvt_pk_bf16(v1[2], v1[3]); return w; }

struct EpiInGate {
    __device__ __forceinline__ bool keep(const Unit&) const { return false; }
    gbf* proj; gbf* gates; const gfl* bgate; GAS unsigned* nmax;
    __device__ __forceinline__ void operator()(const f32x4 (&acc)[2][2][4][2], const Unit& u, int wr, int wc, int fr, int fq) const {
        const int row0 = u.pm * BM + wr * 64 + fr;
        if (u.pn < IN_W / BM) {
            const int col0 = u.pn * BM + wc * 32 + 8 * fq;
            if (u.pn >= OFF_QC / BM && u.pn < OFF_VC / BM) {
#pragma unroll
                for (int bj = 0; bj < 2; ++bj) {
                    float mx = 0.f;
#pragma unroll
                    for (int ai = 0; ai < 2; ++ai)
#pragma unroll
                        for (int m = 0; m < 4; ++m) { const f32x4 a = acc[ai][bj][m][0], e = acc[ai][bj][m][1];
                            float ss = (a[0] * a[0] + a[1] * a[1]) + (a[2] * a[2] + a[3] * a[3]) + (e[0] * e[0] + e[1] * e[1]) + (e[2] * e[2] + e[3] * e[3]);
                            ss += __shfl_xor(ss, 16); ss += __shfl_xor(ss, 32); mx = fmaxf(mx, ss); }
                    mx = fmaxf(mx, __shfl_xor(mx, 1)); mx = fmaxf(mx, __shfl_xor(mx, 2)); mx = fmaxf(mx, __shfl_xor(mx, 4)); mx = fmaxf(mx, __shfl_xor(mx, 8));
                    const int cq = u.pn * BM + bj * HALF + wc * 32 - OFF_QC;
                    const int qk = cq >= (OFF_KC - OFF_QC) ? 1 : 0, g32 = (cq - qk * (OFF_KC - OFF_QC)) >> 5, bb = (u.pm * BM) / T;
                    if (fr == 0 && fq == 0) __hip_atomic_fetch_max(nmax + (qk * BATCH + bb) * 48 + g32, __float_as_uint(mx), __ATOMIC_RELAXED, __HIP_MEMORY_SCOPE_AGENT);
                }
            }
#pragma unroll
            for (int ai = 0; ai < 2; ++ai)
#pragma unroll
                for (int m = 0; m < 4; ++m) { gbf* rowp = proj + (size_t)(row0 + ai * HALF + m * 16) * IN_W + col0;
#pragma unroll
                    for (int bj = 0; bj < 2; ++bj) *(GAS u32x4*)(rowp + bj * HALF) = pack8(acc[ai][bj][m][0], acc[ai][bj][m][1]); }
        } else {
            const int col0 = (u.pn - IN_W / BM) * BM + wc * 32 + 8 * fq;
            f32x4 bv[2][2];
#pragma unroll
            for (int bj = 0; bj < 2; ++bj)
#pragma unroll
                for (int n = 0; n < 2; ++n) bv[bj][n] = *(const GAS f32x4*)(bgate + col0 + bj * HALF + 4 * n);
#pragma unroll
            for (int ai = 0; ai < 2; ++ai)
#pragma unroll
                for (int m = 0; m < 4; ++m) {
#pragma unroll
                    for (int bj = 0; bj < 2; ++bj) { f32x4 v0 = acc[ai][bj][m][0] + bv[bj][0], v1 = acc[ai][bj][m][1] + bv[bj][1];
#pragma unroll
                        for (int j = 0; j < 4; ++j) { v0[j] = fast_sigmoid(v0[j]); v1[j] = fast_sigmoid(v1[j]); }
                        *(GAS u32x4*)((guc*)gates + atile_off(row0 + ai * HALF + m * 16, col0 + bj * HALF, GATE_W / BK)) = pack8(v0, v1); } }
        }
    }
};
struct EpiPool {
    __device__ __forceinline__ bool keep(const Unit&) const { return false; }
    gbf* mix; const gfl* pscale;
    __device__ __forceinline__ void operator()(const f32x4 (&acc)[2][2][4][2], const Unit& u, int wr, int wc, int fr, int fq) const {
        const int row0 = u.pm * BM + wr * 64 + fr, col0 = u.pn * BM + wc * 32 + 8 * fq;
        f32x4 sv[2][2];
#pragma unroll
        for (int bj = 0; bj < 2; ++bj)
#pragma unroll
            for (int n = 0; n < 2; ++n) sv[bj][n] = *(const GAS f32x4*)(pscale + col0 + bj * HALF + 4 * n);
#pragma unroll
        for (int ai = 0; ai < 2; ++ai)
#pragma unroll
            for (int m = 0; m < 4; ++m) {
#pragma unroll
                for (int bj = 0; bj < 2; ++bj) *(GAS u32x4*)((guc*)mix + atile_off(row0 + ai * HALF + m * 16, MIX_B + col0 + bj * HALF, D / BK)) = pack8(acc[ai][bj][m][0] * sv[bj][0], acc[ai][bj][m][1] * sv[bj][1]); }
    }
};
struct EpiBranch {
    const gbf* gates; gbf* merged;
    __device__ __forceinline__ bool keep(const Unit& u) const { return u.seg < 2; }
    __device__ __forceinline__ static void unpack(const u32x4 w, f32x4& lo, f32x4& hi) { lo = (f32x4){bf_lo(w.x), bf_hi(w.x), bf_lo(w.y), bf_hi(w.y)}; hi = (f32x4){bf_lo(w.z), bf_hi(w.z), bf_lo(w.w), bf_hi(w.w)}; }
    __device__ __forceinline__ void operator()(f32x4 (&acc)[2][2][4][2], const Unit& u, int wr, int wc, int fr, int fq) const {
        const int row0 = u.pm * BM + wr * 64 + fr, col0 = u.pn * BM + wc * 32 + 8 * fq;
        const guc* gimg = (const guc*)gates; const int gcol = u.seg * D + col0;
        if (u.seg < 2) {
#pragma unroll
            for (int ai = 0; ai < 2; ++ai) {
                u32x4 gw[4][2], hw[4][2];
#pragma unroll
                for (int m = 0; m < 4; ++m)
#pragma unroll
                    for (int bj = 0; bj < 2; ++bj) { const guc* gp = gimg + atile_off(row0 + ai * HALF + m * 16, gcol + bj * HALF, GATE_W / BK); gw[m][bj] = *(const GAS u32x4*)gp; hw[m][bj] = *(const GAS u32x4*)(gp + (size_t)(D / BK) * (2 * HTB)); }
#pragma unroll
                for (int m = 0; m < 4; ++m)
#pragma unroll
                    for (int bj = 0; bj < 2; ++bj) { f32x4 g0, g1, h0, h1; unpack(gw[m][bj], g0, g1); unpack(hw[m][bj], h0, h1);
#pragma unroll
                        for (int j = 0; j < 4; ++j) { g0[j] = fmaxf(g0[j], 1e-30f) * __builtin_amdgcn_rcpf(fmaxf(h0[j], 1e-30f)); g1[j] = fmaxf(g1[j], 1e-30f) * __builtin_amdgcn_rcpf(fmaxf(h1[j], 1e-30f)); }
                        acc[ai][bj][m][0] *= g0; acc[ai][bj][m][1] *= g1; }
            }
        } else {
#pragma unroll
            for (int ai = 0; ai < 2; ++ai) {
                u32x4 gw[4][2];
#pragma unroll
                for (int m = 0; m < 4; ++m)
#pragma unroll
                    for (int bj = 0; bj < 2; ++bj) gw[m][bj] = *(const GAS u32x4*)(gimg + atile_off(row0 + ai * HALF + m * 16, gcol + bj * HALF, GATE_W / BK));
#pragma unroll
                for (int m = 0; m < 4; ++m)
#pragma unroll
                    for (int bj = 0; bj < 2; ++bj) { f32x4 g0, g1; unpack(gw[m][bj], g0, g1);
#pragma unroll
                        for (int j = 0; j < 4; ++j) { g0[j] = fmaxf(g0[j], 1e-30f); g1[j] = fmaxf(g1[j], 1e-30f); }
                        *(GAS u32x4*)((guc*)merged + atile_off(row0 + ai * HALF + m * 16, col0 + bj * HALF, D / BK)) = pack8(acc[ai][bj][m][0] * g0, acc[ai][bj][m][1] * g1); }
            }
        }
    }
};
struct EpiStore {
    __device__ __forceinline__ bool keep(const Unit&) const { return false; }
    gbf* O; int ldc;
    __device__ __forceinline__ void operator()(const f32x4 (&acc)[2][2][4][2], const Unit& u, int wr, int wc, int fr, int fq) const {
        const int row0 = u.pm * BM + wr * 64 + fr, col0 = u.pn * BM + wc * 32 + 8 * fq;
#pragma unroll
        for (int ai = 0; ai < 2; ++ai)
#pragma unroll
            for (int m = 0; m < 4; ++m) {
#pragma unroll
                for (int bj = 0; bj < 2; ++bj) *(GAS u32x4*)((guc*)O + atile_off(row0 + ai * HALF + m * 16, col0 + bj * HALF, ldc / BK)) = pack8(acc[ai][bj][m][0], acc[ai][bj][m][1]); }
    }
};
struct EpiSwiglu {
    __device__ __forceinline__ bool keep(const Unit&) const { return false; }
    gbf* hid;
    __device__ __forceinline__ void operator()(const f32x4 (&acc)[2][2][4][2], const Unit& u, int wr, int wc, int fr, int fq) const {
        const int row0 = u.pm * BM + wr * 64 + fr, col0 = u.pn * HALF + wc * 32 + 8 * fq;
#pragma unroll
        for (int ai = 0; ai < 2; ++ai)
#pragma unroll
            for (int m = 0; m < 4; ++m) { f32x4 v0, v1;
#pragma unroll
                for (int j = 0; j < 4; ++j) { const float a0 = acc[ai][0][m][0][j], a1 = acc[ai][0][m][1][j];
                    v0[j] = a0 * fast_sigmoid(a0) * acc[ai][1][m][0][j]; v1[j] = a1 * fast_sigmoid(a1) * acc[ai][1][m][1][j]; }
                *(GAS u32x4*)((guc*)hid + atile_off(row0 + ai * HALF + m * 16, col0, FF / BK)) = pack8(v0, v1); }
    }
};
}

constexpr int AT_PITCH = 288, AT_TILE = 64 * AT_PITCH, AT_BUF = 2 * AT_TILE;
template <int NS>
__device__ __forceinline__ void attn_unit(LAS unsigned char* lds, const gbf* __restrict__ proj, gbf* __restrict__ mix, int b, int h, int qb,
                                          float slope2, float sink2, float lam, const gfl* __restrict__ subg, float outscale) {
    const int tid = fresh_tid(), wave = __builtin_amdgcn_readfirstlane(tid >> 6), lane = tid & 63, g = lane >> 4, i16 = lane & 15;
    const int qcol = (NS == 1 ? OFF_QA : OFF_QC) + h * 128;
    const int kcol = (NS == 1 ? OFF_KA + (h / 3) * 128 : OFF_KC + h * 128);
    const int vcol = (NS == 1 ? OFF_VA + (h / 3) * 128 : OFF_VC + h * 128);
    const int tq = qb * 128 + wave * 16 + i16;
    const gbf* rowbase = proj + (size_t)b * T * IN_W;
    bf16x8 qf[4];
#pragma unroll
    for (int kk = 0; kk < 4; ++kk) qf[kk] = *(const GAS bf16x8*)(rowbase + (size_t)tq * IN_W + qcol + kk * 32 + 8 * g);
    int jlo, jhi, kbase;
    if (NS == 1) { kbase = qb * 128 - 128; jlo = (qb == 0) ? 2 : 0; jhi = (qb == T / 128 - 1) ? 4 : 6; } else { kbase = 0; jlo = 0; jhi = T / 64; }
    const float c1 = (NS == 1 ? 0.08838834764831845f : 0.125f) * LOG2E;
    f32x4 O[NS][8]; float mrun[NS], lrun[NS];
#pragma unroll
    for (int s = 0; s < NS; ++s) { mrun[s] = (NS == 1) ? sink2 : -1e30f; lrun[s] = (NS == 1 && g == 0) ? 1.0f : 0.0f;
#pragma unroll
        for (int dt = 0; dt < 8; ++dt) O[s][dt] = (f32x4){0.f, 0.f, 0.f, 0.f}; }
    const int skey = tid >> 4, sch = tid & 15;
    u32x4 kreg[2], vreg[2];
    auto gload = [&](int j) { const int kp0 = kbase + 64 * j;
#pragma unroll
        for (int i = 0; i < 2; ++i) { const gbf* rp = rowbase + (size_t)(kp0 + skey + 32 * i) * IN_W + sch * 8;
            kreg[i] = *(const GAS u32x4*)(rp + kcol); vreg[i] = *(const GAS u32x4*)(rp + vcol); } };
    auto lstore = [&](int buf) { LAS unsigned char* bp = lds + buf * AT_BUF + (skey) * AT_PITCH + sch * 16;
#pragma unroll
        for (int i = 0; i < 2; ++i) { *(LAS u32x4*)(bp + i * 32 * AT_PITCH) = kreg[i]; *(LAS u32x4*)(bp + AT_TILE + i * 32 * AT_PITCH) = vreg[i]; } };
    gload(jlo);
    __syncthreads();
    lstore(0);
    __syncthreads();
    const int koff = i16 * AT_PITCH + 16 * g;
    const int voff = AT_TILE + (4 * g + (i16 >> 2)) * AT_PITCH + (i16 & 3) * 8;
    float slo[4][4];
#pragma unroll
    for (int kt = 0; kt < 4; ++kt)
#pragma unroll
        for (int r = 0; r < 4; ++r) slo[kt][r] = slope2 * (float)(kt * 16 + 4 * g + r);
    const int tqw = qb * 128 + wave * 16;
    constexpr float THR = 8.0f;
    for (int j = jlo; j < jhi; ++j) {
        const int buf = (j - jlo) & 1;
        if (j + 1 < jhi) gload(j + 1);
        LAS unsigned char* bp = lds + buf * AT_BUF;
        const int kp0 = kbase + 64 * j;
        f32x4 st[NS][4];
#pragma unroll
        for (int s = 0; s < NS; ++s)
#pragma unroll
            for (int kt = 0; kt < 4; ++kt) { st[s][kt] = (f32x4){0.f, 0.f, 0.f, 0.f};
#pragma unroll
                for (int kk = 0; kk < 4 / NS; ++kk) { const int kq = s * (4 / NS) + kk;
                    const bf16x8 kf = *(const LAS bf16x8*)(bp + koff + kt * 16 * AT_PITCH + kq * 64);
                    st[s][kt] = __builtin_amdgcn_mfma_f32_16x16x32_bf16(kf, qf[kq], st[s][kt], 0, 0, 0); } }
        f32x4 B[4];
        const float d0 = (float)(tq - kp0);
        if (kp0 + 63 <= tqw) {
            const float c0 = -slope2 * d0;
#pragma unroll
            for (int kt = 0; kt < 4; ++kt)
#pragma unroll
                for (int r = 0; r < 4; ++r) B[kt][r] = c0 + slo[kt][r];
        } else if (kp0 >= tqw + 15) {
            const float c0 = slope2 * d0;
#pragma unroll
            for (int kt = 0; kt < 4; ++kt)
#pragma unroll
                for (int r = 0; r < 4; ++r) B[kt][r] = c0 - slo[kt][r];
        } else {
#pragma unroll
            for (int kt = 0; kt < 4; ++kt)
#pragma unroll
                for (int r = 0; r < 4; ++r) { const float ad = fabsf(d0 - (float)(kt * 16 + 4 * g + r)); float bb = -slope2 * ad; if (NS == 1) bb = (ad <= 128.0f) ? bb : -1e30f; B[kt][r] = bb; }
        }
        if (NS == 1 && (kp0 + 63 <= tqw || kp0 >= tqw + 15)) {
#pragma unroll
            for (int kt = 0; kt < 4; ++kt)
#pragma unroll
                for (int r = 0; r < 4; ++r) { const float ad = fabsf(d0 - (float)(kt * 16 + 4 * g + r)); B[kt][r] = (ad <= 128.0f) ? B[kt][r] : -1e30f; }
        }
        bf16x8 pf[NS][2];
#pragma unroll
        for (int s = 0; s < NS; ++s) {
            float tmax = -1e30f;
#pragma unroll
            for (int kt = 0; kt < 4; ++kt) {
#pragma unroll
                for (int r = 0; r < 4; ++r) st[s][kt][r] = fmaf(st[s][kt][r], c1, B[kt][r]);
                tmax = fmaxf(tmax, fmaxf(fmaxf(st[s][kt][0], st[s][kt][1]), fmaxf(st[s][kt][2], st[s][kt][3]))); }
            if (__any(tmax > mrun[s] + THR)) {
                tmax = fmaxf(tmax, __shfl_xor(tmax, 16)); tmax = fmaxf(tmax, __shfl_xor(tmax, 32));
                const float mnew = fmaxf(mrun[s], tmax), alpha = __builtin_amdgcn_exp2f(mrun[s] - mnew); mrun[s] = mnew;
                lrun[s] *= alpha;
#pragma unroll
                for (int dt = 0; dt < 8; ++dt) O[s][dt] *= alpha;
            }
            const float mcur = mrun[s];
            float psum = 0.f;
#pragma unroll
            for (int kt = 0; kt < 4; ++kt)
#pragma unroll
                for (int r = 0; r < 4; ++r) { const float p = __builtin_amdgcn_exp2f(st[s][kt][r] - mcur); st[s][kt][r] = p; psum += p; }
            lrun[s] += psum;
#pragma unroll
            for (int k2 = 0; k2 < 2; ++k2) { u32x4 w; w.x = cvt_pk_bf16(st[s][2 * k2][0], st[s][2 * k2][1]); w.y = cvt_pk_bf16(st[s][2 * k2][2], st[s][2 * k2][3]);
                w.z = cvt_pk_bf16(st[s][2 * k2 + 1][0], st[s][2 * k2 + 1][1]); w.w = cvt_pk_bf16(st[s][2 * k2 + 1][2], st[s][2 * k2 + 1][3]); pf[s][k2] = __builtin_bit_cast(bf16x8, w); }
        }
#pragma unroll
        for (int dt = 0; dt < 8; ++dt)
#pragma unroll
            for (int k2 = 0; k2 < 2; ++k2) {
                const s16x4 lo = __builtin_bit_cast(s16x4, __builtin_amdgcn_ds_read_tr16_b64_v4i16((LAS s16x4*)(bp + voff + (k2 * 32) * AT_PITCH + dt * 32)));
                const s16x4 hi = __builtin_bit_cast(s16x4, __builtin_amdgcn_ds_read_tr16_b64_v4i16((LAS s16x4*)(bp + voff + (k2 * 32 + 16) * AT_PITCH + dt * 32)));
                const bf16x8 vf = {lo[0], lo[1], lo[2], lo[3], hi[0], hi[1], hi[2], hi[3]};
#pragma unroll
                for (int s = 0; s < NS; ++s) O[s][dt] = __builtin_amdgcn_mfma_f32_16x16x32_bf16(vf, pf[s][k2], O[s][dt], 0, 0, 0);
            }
        if (j + 1 < jhi) lstore(buf ^ 1);
        __syncthreads();
    }
    float inv[NS];
#pragma unroll
    for (int s = 0; s < NS; ++s) { float l = lrun[s]; l += __shfl_xor(l, 16); l += __shfl_xor(l, 32); inv[s] = 1.0f / l; }
    const int orow_r = b * T + tq, ocol = (NS == 1 ? 0 : MIX_C) + h * 128 + 4 * g;
    if (NS == 1) {
#pragma unroll
        for (int dt = 0; dt < 8; ++dt) { const f32x4 o = O[0][dt] * inv[0]; u32x2 w; w.x = cvt_pk_bf16(o[0], o[1]); w.y = cvt_pk_bf16(o[2], o[3]); *(GAS u32x2*)((guc*)mix + pg8::atile_off(orow_r, ocol + 16 * dt, D / 64)) = w; }
    } else {
        float ss = 0.f;
#pragma unroll
        for (int dt = 0; dt < 8; ++dt) { O[0][dt] = O[0][dt] * inv[0] - (O[NS - 1][dt] * inv[NS - 1]) * lam; const f32x4 o = O[0][dt]; ss += (o[0] * o[0] + o[1] * o[1]) + (o[2] * o[2] + o[3] * o[3]); }
        ss += __shfl_xor(ss, 16); ss += __shfl_xor(ss, 32);
        const float rs = rsqrtf(ss * (1.0f / 128.0f) + SUBLN_EPS) * outscale;
#pragma unroll
        for (int dt = 0; dt < 8; ++dt) { const f32x4 gv = *(const GAS f32x4*)(subg + 16 * dt + 4 * g); const f32x4 o = O[0][dt] * rs * gv;
            u32x2 w; w.x = cvt_pk_bf16(o[0], o[1]); w.y = cvt_pk_bf16(o[2], o[3]); *(GAS u32x2*)((guc*)mix + pg8::atile_off(orow_r, ocol + 16 * dt, D / 64)) = w; }
    }
}


constexpr int NTC = T / 64;
__device__ __forceinline__ void attn_c_fast(LAS unsigned char* lds, const gbf* __restrict__ proj, gbf* __restrict__ mix, int b, int h, int qb,
                                            float slope2, float lam, const gfl* __restrict__ subg, float outscale, float kmax2_0, float kmax2_1) {
    const int tid = fresh_tid(), wave = __builtin_amdgcn_readfirstlane(tid >> 6), lane = tid & 63, g = lane >> 4, i16 = lane & 15;
    const int qcol = OFF_QC + h * 128, kcol = OFF_KC + h * 128, vcol = OFF_VC + h * 128;
    const int tq = qb * 128 + wave * 16 + i16, tqw = qb * 128 + wave * 16;
    const gbf* rowbase = proj + (size_t)b * T * IN_W;
    const float c1 = 0.125f * LOG2E;
    bf16x8 qf[4];
#pragma unroll
    for (int kk = 0; kk < 4; ++kk) qf[kk] = *(const GAS bf16x8*)(rowbase + (size_t)tq * IN_W + qcol + kk * 32 + 8 * g);
    float mref[2];
#pragma unroll
    for (int s = 0; s < 2; ++s) { float ss = 0.f;
#pragma unroll
        for (int kk = 0; kk < 2; ++kk)
#pragma unroll
            for (int e = 0; e < 8; ++e) { const float v = __uint_as_float(((unsigned)(unsigned short)qf[2 * s + kk][e]) << 16); ss += v * v; }
        ss += __shfl_xor(ss, 16); ss += __shfl_xor(ss, 32);
        mref[s] = c1 * sqrtf(ss * (s == 0 ? kmax2_0 : kmax2_1)) + 1.0f; }
    float slo[4][4];
#pragma unroll
    for (int kt = 0; kt < 4; ++kt)
#pragma unroll
        for (int r = 0; r < 4; ++r) slo[kt][r] = (float)(kt * 16 + 4 * g + r);
    f32x4 O[2][8]; float lrun[2] = {0.f, 0.f};
#pragma unroll
    for (int s = 0; s < 2; ++s)
#pragma unroll
        for (int dt = 0; dt < 8; ++dt) O[s][dt] = (f32x4){0.f, 0.f, 0.f, 0.f};
    const int skey = tid >> 4, sch = tid & 15;
    u32x4 kreg[2], vreg[2];
    const gbf* sbase = rowbase + (size_t)skey * IN_W + sch * 8;
    LAS unsigned char* sdst = lds + skey * AT_PITCH + sch * 16;
#define C_GLOADK(j) do { _Pragma("unroll") for (int i_ = 0; i_ < 2; ++i_) kreg[i_] = *(const GAS u32x4*)(sbase + (size_t)(64 * (j) + 32 * i_) * IN_W + kcol); } while (0)
#define C_GLOADV(j) do { _Pragma("unroll") for (int i_ = 0; i_ < 2; ++i_) vreg[i_] = *(const GAS u32x4*)(sbase + (size_t)(64 * (j) + 32 * i_) * IN_W + vcol); } while (0)
#define C_LSTK(bi) do { _Pragma("unroll") for (int i_ = 0; i_ < 2; ++i_) *(LAS u32x4*)(sdst + (bi) * AT_TILE + i_ * 32 * AT_PITCH) = kreg[i_]; } while (0)
#define C_LSTV(bi) do { _Pragma("unroll") for (int i_ = 0; i_ < 2; ++i_) *(LAS u32x4*)(sdst + (2 + (bi)) * AT_TILE + i_ * 32 * AT_PITCH) = vreg[i_]; } while (0)
    const int koff = i16 * AT_PITCH + 16 * g;
    const int voff = 2 * AT_TILE + (4 * g + (i16 >> 2)) * AT_PITCH + (i16 & 3) * 8;
    u32x4 k1reg[2];
    C_GLOADK(0); C_GLOADV(0);
#pragma unroll
    for (int i_ = 0; i_ < 2; ++i_) k1reg[i_] = *(const GAS u32x4*)(sbase + (size_t)(64 + 32 * i_) * IN_W + kcol);
#define C_S(kb, stx) do { \
        _Pragma("unroll") for (int s_ = 0; s_ < 2; ++s_) _Pragma("unroll") for (int kt_ = 0; kt_ < 4; ++kt_) { stx[s_][kt_] = (f32x4){0.f, 0.f, 0.f, 0.f}; \
            _Pragma("unroll") for (int kk_ = 0; kk_ < 2; ++kk_) { const bf16x8 kf_ = *(const LAS bf16x8*)(lds + (kb) * AT_TILE + koff + kt_ * 16 * AT_PITCH + (2 * s_ + kk_) * 64); \
                stx[s_][kt_] = __builtin_amdgcn_mfma_f32_16x16x32_bf16(kf_, qf[2 * s_ + kk_], stx[s_][kt_], 0, 0, 0); } } \
    } while (0)
#define C_EXP(t, stx, pfo) do { \
        const float d0_ = (float)(tq - 64 * (t)); f32x4 B_[4]; \
        _Pragma("unroll") for (int kt_ = 0; kt_ < 4; ++kt_) _Pragma("unroll") for (int r_ = 0; r_ < 4; ++r_) B_[kt_][r_] = fabsf(d0_ - slo[kt_][r_]);     \
        _Pragma("unroll") for (int s_ = 0; s_ < 2; ++s_) { float ps_ = 0.f; const float nm_ = -mref[s_]; \
            _Pragma("unroll") for (int kt_ = 0; kt_ < 4; ++kt_) _Pragma("unroll") for (int r_ = 0; r_ < 4; ++r_) { const float p_ = __builtin_amdgcn_exp2f(fmaf(stx[s_][kt_][r_], c1, fmaf(-slope2, B_[kt_][r_], nm_))); stx[s_][kt_][r_] = p_; ps_ += p_; } \
            lrun[s_] += ps_; \
            _Pragma("unroll") for (int k2_ = 0; k2_ < 2; ++k2_) { u32x4 w_; w_.x = cvt_pk_bf16(stx[s_][2 * k2_][0], stx[s_][2 * k2_][1]); w_.y = cvt_pk_bf16(stx[s_][2 * k2_][2], stx[s_][2 * k2_][3]); \
                w_.z = cvt_pk_bf16(stx[s_][2 * k2_ + 1][0], stx[s_][2 * k2_ + 1][1]); w_.w = cvt_pk_bf16(stx[s_][2 * k2_ + 1][2], stx[s_][2 * k2_ + 1][3]); pfo[s_][k2_] = __builtin_bit_cast(bf16x8, w_); } } \
    } while (0)
#define C_PV(vb, pfi) do { \
        _Pragma("unroll") for (int dt_ = 0; dt_ < 8; ++dt_) _Pragma("unroll") for (int k2_ = 0; k2_ < 2; ++k2_) { \
            const s16x4 lo_ = __builtin_bit_cast(s16x4, __builtin_amdgcn_ds_read_tr16_b64_v4i16((LAS s16x4*)(lds + (vb) * AT_TILE + voff + (k2_ * 32) * AT_PITCH + dt_ * 32))); \
            const s16x4 hi_ = __builtin_bit_cast(s16x4, __builtin_amdgcn_ds_read_tr16_b64_v4i16((LAS s16x4*)(lds + (vb) * AT_TILE + voff + (k2_ * 32 + 16) * AT_PITCH + dt_ * 32))); \
            const bf16x8 vf_ = {lo_[0], lo_[1], lo_[2], lo_[3], hi_[0], hi_[1], hi_[2], hi_[3]}; \
            _Pragma("unroll") for (int s_ = 0; s_ < 2; ++s_) O[s_][dt_] = __builtin_amdgcn_mfma_f32_16x16x32_bf16(vf_, pfi[s_][k2_], O[s_][dt_], 0, 0, 0); } \
    } while (0)
    __syncthreads();
    C_LSTK(0); C_LSTV(0);
#pragma unroll
    for (int i_ = 0; i_ < 2; ++i_) *(LAS u32x4*)(sdst + 1 * AT_TILE + i_ * 32 * AT_PITCH) = k1reg[i_];
    __syncthreads();
    bf16x8 pf[2][2], pfn[2][2];
    { f32x4 st0[2][4]; C_S(0, st0); C_EXP(0, st0, pf); }
    __syncthreads();
#pragma nounroll
    for (int j = 0; j < NTC - 1; ++j) {
        const int jk = (j + 2 < NTC) ? j + 2 : NTC - 1;
        C_GLOADK(jk); C_GLOADV(j + 1);
        const LAS unsigned char* kbp = lds + ((j + 1) & 1) * AT_TILE + koff;
        const LAS unsigned char* vbp = lds + (j & 1) * AT_TILE + voff;
        f32x4 stn[2][4]; bf16x8 kfr[3][4], vfr[3][2];
#define C_LDK(kt, bi) do { _Pragma("unroll") for (int q_ = 0; q_ < 4; ++q_) kfr[bi][q_] = *(const LAS bf16x8*)(kbp + (kt) * 16 * AT_PITCH + q_ * 64); } while (0)
#define C_LDV(dt, bi) do { _Pragma("unroll") for (int k2_ = 0; k2_ < 2; ++k2_) { \
            const s16x4 lo_ = __builtin_bit_cast(s16x4, __builtin_amdgcn_ds_read_tr16_b64_v4i16((LAS s16x4*)(vbp + (k2_ * 32) * AT_PITCH + (dt) * 32))); \
            const s16x4 hi_ = __builtin_bit_cast(s16x4, __builtin_amdgcn_ds_read_tr16_b64_v4i16((LAS s16x4*)(vbp + (k2_ * 32 + 16) * AT_PITCH + (dt) * 32))); \
            vfr[bi][k2_] = (bf16x8){lo_[0], lo_[1], lo_[2], lo_[3], hi_[0], hi_[1], hi_[2], hi_[3]}; } } while (0)
        C_LDK(0, 0); C_LDK(1, 1);
#pragma unroll
        for (int kt = 0; kt < 4; ++kt) {
            __builtin_amdgcn_sched_barrier(0);
            if (kt < 2) C_LDK(kt + 2, (kt + 2) % 3); else C_LDV(kt - 2, kt - 2);
#pragma unroll
            for (int s_ = 0; s_ < 2; ++s_) { stn[s_][kt] = (f32x4){0.f, 0.f, 0.f, 0.f};
#pragma unroll
                for (int kk = 0; kk < 2; ++kk) stn[s_][kt] = __builtin_amdgcn_mfma_f32_16x16x32_bf16(kfr[kt % 3][2 * s_ + kk], qf[2 * s_ + kk], stn[s_][kt], 0, 0, 0); }
        }
        const float dq = (float)(tq - 64 * (j + 1) - 4 * g);
        float ps0 = 0.f, ps1 = 0.f; const float nm0 = -mref[0], nm1 = -mref[1];
#pragma unroll
        for (int dt = 0; dt < 8; ++dt) {
            __builtin_amdgcn_sched_barrier(0);
            if (dt < 6) C_LDV(dt + 2, (dt + 2) % 3);
#pragma unroll
            for (int k2 = 0; k2 < 2; ++k2)
#pragma unroll
                for (int s_ = 0; s_ < 2; ++s_) O[s_][dt] = __builtin_amdgcn_mfma_f32_16x16x32_bf16(vfr[dt % 3][k2], pf[s_][k2], O[s_][dt], 0, 0, 0);
#pragma unroll
            for (int rr = 0; rr < 2; ++rr) { const int kt = dt >> 1, r = 2 * (dt & 1) + rr; const float bb = -slope2 * fabsf(dq - (float)(kt * 16 + r));
                const float p0 = __builtin_amdgcn_exp2f(fmaf(stn[0][kt][r], c1, bb + nm0)), p1 = __builtin_amdgcn_exp2f(fmaf(stn[1][kt][r], c1, bb + nm1));
                stn[0][kt][r] = p0; stn[1][kt][r] = p1; ps0 += p0; ps1 += p1; }
        }
        __builtin_amdgcn_sched_barrier(0);
#undef C_LDK
#undef C_LDV
        lrun[0] += ps0; lrun[1] += ps1;
#pragma unroll
        for (int s_ = 0; s_ < 2; ++s_)
#pragma unroll
            for (int k2 = 0; k2 < 2; ++k2) { u32x4 w_; w_.x = cvt_pk_bf16(stn[s_][2 * k2][0], stn[s_][2 * k2][1]); w_.y = cvt_pk_bf16(stn[s_][2 * k2][2], stn[s_][2 * k2][3]);
                w_.z = cvt_pk_bf16(stn[s_][2 * k2 + 1][0], stn[s_][2 * k2 + 1][1]); w_.w = cvt_pk_bf16(stn[s_][2 * k2 + 1][2], stn[s_][2 * k2 + 1][3]); pfn[s_][k2] = __builtin_bit_cast(bf16x8, w_); }
        C_LSTK(j & 1); C_LSTV((j + 1) & 1);
        __syncthreads();
#pragma unroll
        for (int s = 0; s < 2; ++s)
#pragma unroll
            for (int k2 = 0; k2 < 2; ++k2) pf[s][k2] = pfn[s][k2];
    }
    C_PV((NTC - 1) & 1, pf);
#undef C_GLOADK
#undef C_GLOADV
#undef C_LSTK
#undef C_LSTV
#undef C_S
#undef C_EXP
#undef C_PV
    float inv[2];
#pragma unroll
    for (int s = 0; s < 2; ++s) { float l = lrun[s]; l += __shfl_xor(l, 16); l += __shfl_xor(l, 32); inv[s] = 1.0f / l; }
    const int orow_r = b * T + tq, ocol = MIX_C + h * 128 + 4 * g;
    float ss = 0.f;
#pragma unroll
    for (int dt = 0; dt < 8; ++dt) { O[0][dt] = O[0][dt] * inv[0] - (O[1][dt] * inv[1]) * lam; const f32x4 o = O[0][dt]; ss += (o[0] * o[0] + o[1] * o[1]) + (o[2] * o[2] + o[3] * o[3]); }
    ss += __shfl_xor(ss, 16); ss += __shfl_xor(ss, 32);
    const float rs = rsqrtf(ss * (1.0f / 128.0f) + SUBLN_EPS) * outscale;
#pragma unroll
    for (int dt = 0; dt < 8; ++dt) { const f32x4 gv = *(const GAS f32x4*)(subg + 16 * dt + 4 * g); const f32x4 o = O[0][dt] * rs * gv;
        u32x2 w; w.x = cvt_pk_bf16(o[0], o[1]); w.y = cvt_pk_bf16(o[2], o[3]); *(GAS u32x2*)((guc*)mix + pg8::atile_off(orow_r, ocol + 16 * dt, D / 64)) = w; }
}

__device__ __forceinline__ void transpose_item(const gfl* __restrict__ W, int N, int k0, int n0, guc* __restrict__ dimg, int r0, int nkt, LAS float* scr, int lane) {
#pragma unroll 8
    for (int i = 0; i < 32; ++i) { const int kk = 2 * i + (lane >> 5); scr[kk * 33 + (lane & 31)] = W[(size_t)(k0 + kk) * N + n0 + (lane & 31)]; }
    LDS_WAIT(); asm volatile("" ::: "memory");
    const int c = lane & 7;
#pragma unroll
    for (int j = 0; j < 4; ++j) { const int n = (lane >> 3) + 8 * j; const LAS float* s = scr + (8 * c) * 33 + n;
        u32x4 o; o.x = cvt_pk_bf16(s[0 * 33], s[1 * 33]); o.y = cvt_pk_bf16(s[2 * 33], s[3 * 33]); o.z = cvt_pk_bf16(s[4 * 33], s[5 * 33]); o.w = cvt_pk_bf16(s[6 * 33], s[7 * 33]);
        *(GAS u32x4*)(dimg + pg8::btile_off(r0 + n, k0 >> 6, c, nkt)) = o; }
    LDS_WAIT(); asm volatile("" ::: "memory");
}

__device__ __forceinline__ void acc8(float (&s)[8], u32x4 w, float sg) {
    asm volatile("" : "+v"(w));
    s[0] += sg * bf_lo(w.x); s[1] += sg * bf_hi(w.x); s[2] += sg * bf_lo(w.y); s[3] += sg * bf_hi(w.y); s[4] += sg * bf_lo(w.z); s[5] += sg * bf_hi(w.z); s[6] += sg * bf_lo(w.w); s[7] += sg * bf_hi(w.w);
}
template <int R>
__device__ __forceinline__ void stencil_block(const gbf* __restrict__ up, int t0, guc* __restrict__ zimg, int m0, int ch) {
    guc* zlo = zimg + pg8::atile_off(m0, ch * 8, POOLW / 64); guc* zhi = zimg + pg8::atile_off(m0 + 8, ch * 8, POOLW / 64);
    u32x4 wv[16 + 2 * R];
#pragma unroll
    for (int k = 0; k < 16 + 2 * R; ++k) { const int q = t0 - R + k; const bool ok = (q >= 0) && (q < T); wv[k] = *(const GAS u32x4*)(up + (size_t)(ok ? q : t0) * IN_W); }
    __builtin_amdgcn_sched_barrier(0);
#pragma unroll
    for (int k = 0; k < 16 + 2 * R; ++k) { const int q = t0 - R + k; const bool ok = (q >= 0) && (q < T); if (!ok) wv[k] = (u32x4){0u, 0u, 0u, 0u}; }
    float s[8];
#pragma unroll
    for (int j = 0; j < 8; ++j) s[j] = 0.f;
#pragma unroll
    for (int k = 0; k < 2 * R + 1; ++k) acc8(s, wv[k], 1.0f);
#pragma unroll
    for (int i = 0; i < 16; ++i) {
        const int t = t0 + i, tlo = (t - R < 0) ? 0 : t - R, thi = (t + R + 1 > T) ? T : t + R + 1; const float ic = __builtin_amdgcn_rcpf((float)(thi - tlo));
        u32x4 w = wv[R + i]; asm volatile("" : "+v"(w));
        u32x4 o; o.x = cvt_pk_bf16(s[0] * ic - bf_lo(w.x), s[1] * ic - bf_hi(w.x)); o.y = cvt_pk_bf16(s[2] * ic - bf_lo(w.y), s[3] * ic - bf_hi(w.y));
        o.z = cvt_pk_bf16(s[4] * ic - bf_lo(w.z), s[5] * ic - bf_hi(w.z)); o.w = cvt_pk_bf16(s[6] * ic - bf_lo(w.w), s[7] * ic - bf_hi(w.w));
        *(GAS u32x4*)((i < 8 ? zlo : zhi) + (i & 7) * 64) = o;
        if (i < 15) { acc8(s, wv[i + 2 * R + 1], 1.0f); acc8(s, wv[i], -1.0f); }
    }
}

struct Args { const float* in[21]; float* out; unsigned char* ws; int ph_lo, ph_hi; };
enum { I_X = 0, I_C, I_ADAW, I_ADAB, I_MPRE, I_MPOST, I_WIN, I_SINK, I_POOLW, I_PSCALE, I_LAMBDA, I_SUBG, I_WGATE, I_BGATE, I_WBRANCH, I_WOUT, I_FPRE, I_FPOST, I_FWG, I_FWU, I_FWD };

template <bool SRC_BF, bool DST_BF>
__device__ __forceinline__ void rownorm_phase(const void GAS* xsrc_, void GAS* xdst_, const gbf* y, const gfl* gpost, const gfl* gate,
                                              const gfl* gpre, const gfl* shift, const gfl* scale, gbf* hdst, int bx, int G, LAS unsigned char* lds) {
    const int tid = fresh_tid(), lane = tid & 63, wave = __builtin_amdgcn_readfirstlane(tid >> 6);
    const bool al = (G & 7) == 0;
    const int b0 = al ? (bx & 7) : 0, bstep = al ? 8 : 1, cb = al ? (bx >> 3) : bx, nb = al ? (G >> 3) : G;
    LAS float* pa = (LAS float*)lds; LAS float* pb = pa + D; LAS float* pc = pb + D;
    for (int b = b0; b < BATCH; b += bstep) {
        __syncthreads();
        { const int c0 = tid * 8;
#pragma unroll
          for (int q = 0; q < 2; ++q) { const int c = c0 + 4 * q;
            if (y) { const f32x4 g = *(const GAS f32x4*)(gate + (size_t)b * ADA + c), p = *(const GAS f32x4*)(gpost + c); *(LAS f32x4*)(pa + c) = g * p; }
            if (hdst) { const f32x4 p = *(const GAS f32x4*)(gpre + c), sc = *(const GAS f32x4*)(scale + (size_t)b * ADA + c), sh = *(const GAS f32x4*)(shift + (size_t)b * ADA + c);
                *(LAS f32x4*)(pb + c) = p * (1.0f + sc); *(LAS f32x4*)(pc + c) = sh; } } }
        __syncthreads();
        constexpr int NR = SRC_BF ? 2 : 1;
        constexpr int QS = 8;
        for (int r = cb * 8 * NR + wave; r < T; r += NR * nb * 8) {
            u32x2 xw[NR][16], yw[NR][16]; f32x4 xf[SRC_BF ? 1 : 16];
#pragma unroll
            for (int q = 0; q < NR; ++q) { const int rq = (r + q * QS < T) ? r + q * QS : r; const int m = b * T + rq; const size_t ro = (size_t)m * D + 4 * lane;
                if constexpr (SRC_BF) {
#pragma unroll
                    for (int j = 0; j < 16; ++j) xw[q][j] = *(const GAS u32x2*)((const gbf*)xsrc_ + ro + 256 * j);
                } else {
#pragma unroll
                    for (int j = 0; j < 16; ++j) xf[j] = *(const GAS f32x4*)((const gfl*)xsrc_ + ro + 256 * j);
                }
                if (y) {
#pragma unroll
                    for (int j = 0; j < 16; ++j) yw[q][j] = *(const GAS u32x2*)((const guc*)y + pg8::atile_off(m, 4 * lane + 256 * j, D / 64));
                } }
#pragma unroll
            for (int q = 0; q < NR; ++q) {
                if (r + q * QS >= T) break;
                const int m = b * T + r + q * QS; const size_t ro = (size_t)m * D + 4 * lane;
                f32x4 xv[16];
#pragma unroll
                for (int j = 0; j < 16; ++j) { if constexpr (SRC_BF) xv[j] = (f32x4){bf_lo(xw[q][j].x), bf_hi(xw[q][j].x), bf_lo(xw[q][j].y), bf_hi(xw[q][j].y)}; else xv[j] = xf[j]; }
                if (y) {
                    float ss = 0.f;
#pragma unroll
                    for (int j = 0; j < 16; ++j) { const f32x4 yv = {bf_lo(yw[q][j].x), bf_hi(yw[q][j].x), bf_lo(yw[q][j].y), bf_hi(yw[q][j].y)}; ss += (yv[0] * yv[0] + yv[1] * yv[1]) + (yv[2] * yv[2] + yv[3] * yv[3]); }
                    const float rstd = rsqrtf(wave_sum(ss) * (1.0f / D) + NORM_EPS);
#pragma unroll
                    for (int j = 0; j < 16; ++j) { const f32x4 av = *(const LAS f32x4*)(pa + 4 * lane + 256 * j);
                        const f32x4 yv = {bf_lo(yw[q][j].x), bf_hi(yw[q][j].x), bf_lo(yw[q][j].y), bf_hi(yw[q][j].y)};
                        xv[j] += av * (yv * rstd);
                        if constexpr (DST_BF) { u32x2 w; w.x = cvt_pk_bf16(xv[j][0], xv[j][1]); w.y = cvt_pk_bf16(xv[j][2], xv[j][3]); *(GAS u32x2*)((gbf*)xdst_ + ro + 256 * j) = w;
                            xv[j] = (f32x4){bf_lo(w.x), bf_hi(w.x), bf_lo(w.y), bf_hi(w.y)}; }
                        else *(GAS f32x4*)((gfl*)xdst_ + ro + 256 * j) = xv[j];
                        if ((j & 3) == 3) asm volatile("" ::: "memory"); }
                }
                if (hdst) {
                    float ss = 0.f;
#pragma unroll
                    for (int j = 0; j < 16; ++j) ss += (xv[j][0] * xv[j][0] + xv[j][1] * xv[j][1]) + (xv[j][2] * xv[j][2] + xv[j][3] * xv[j][3]);
                    const float rstd = rsqrtf(wave_sum(ss) * (1.0f / D) + NORM_EPS);
#pragma unroll
                    for (int j = 0; j < 16; ++j) { const f32x4 bv = *(const LAS f32x4*)(pb + 4 * lane + 256 * j), cv = *(const LAS f32x4*)(pc + 4 * lane + 256 * j);
                        const f32x4 hv = (xv[j] * rstd) * bv + cv; u32x2 w; w.x = cvt_pk_bf16(hv[0], hv[1]); w.y = cvt_pk_bf16(hv[2], hv[3]); *(GAS u32x2*)((guc*)hdst + pg8::atile_off(m, 4 * lane + 256 * j, D / 64)) = w;
                        if ((j & 3) == 3) asm volatile("" ::: "memory"); }
                }
            }
        }
    }
    __syncthreads();
}

__global__ void __launch_bounds__(512, 2) fwd(Args a) {
    extern __shared__ __attribute__((aligned(16))) unsigned char lds_raw[];
    LAS unsigned char* lds = (LAS unsigned char*)lds_raw;
    unsigned* ctl = (unsigned*)(a.ws + WS_CTL);
    volatile LAS unsigned* MISC = (volatile LAS unsigned*)(lds + MISC_OFF);
    for (int u = threadIdx.x; u < (LDS_BYTES - LDSCTL_OFF) / 4; u += 512) ((LAS unsigned*)(lds + LDSCTL_OFF))[u] = 0u;
    __syncthreads();
    const int lo = a.ph_lo, hi = a.ph_hi;
    XcdBarrier bar; bar.bar = ctl + CW_BAR; bar.x = 0; bar.st = nullptr;
    if (hi - lo > 1) bar = xcd_barrier_post(ctl + CW_BAR, MISC + 8);
#define IN(k) (lo <= (k) && (k) < hi)
#define SEAM(k) do { if (IN(k) && IN((k) + 1)) xcd_barrier(bar); } while (0)
#define INP(k) ((const gfl*)a.in[opq(k)])
#define WSB ((guc*)opqp(a.ws))
#define MODP ((gfl*)(WSB + WS_MOD))
#define HB ((gbf*)(WSB + WS_H))
#define MIXP ((gbf*)(WSB + WS_MIX))
#define MERGP ((gbf*)(WSB + WS_MERG))
#define YB ((gbf*)(WSB + WS_Y))
#define XBP ((gbf*)(WSB + WS_M32))
#define ZB ((gbf*)(WSB + WS_Z))
#define PROJP ((gbf*)(WSB + WS_PROJ))
#define GATESP ((gbf*)(WSB + WS_GATES))
#define HIDP ((gbf*)(WSB + WS_HID))
#define WLAYER(l) (WSB + WS_W + (size_t)(l) * W_LAYER)
#define GEOM() const int G = opq((int)gridDim.x), bx = opq((int)blockIdx.x), vcu = (G % 8 == 0) ? (bx % 8) * (G / 8) + bx / 8 : bx; (void)vcu

    if (IN(0)) {
        GEOM();
        {
            constexpr int SW = 192, CQ = SW / 4, KG = 10;
            LAS float* cond = (LAS float*)lds;
            const int tid = fresh_tid();
            const int cq = tid % CQ, kg = tid / CQ;
            const gfl* cin = INP(I_C); const gfl* adaw = INP(I_ADAW); const gfl* adab = INP(I_ADAB); gfl* mod = MODP;
            for (int slab = vcu; slab < DEPTH * ADA / SW; slab += G) {
                const int l = slab / (ADA / SW), col0 = (slab % (ADA / SW)) * SW;
                for (int i = tid; i < BATCH * D; i += 512) { const int b = i / D, k = i % D; const float v = cin[i]; cond[k * 8 + b] = v / (1.0f + __expf(-v)); }
                __syncthreads();
                float acc[8][4];
#pragma unroll
                for (int b = 0; b < 8; ++b)
#pragma unroll
                    for (int j = 0; j < 4; ++j) acc[b][j] = 0.f;
                if (kg < KG) {
                    const gfl* wp = adaw + (size_t)l * D * ADA + col0 + cq * 4;
#pragma unroll 4
                    for (int k = kg; k < D; k += KG) {
                        const f32x4 w = *(const GAS f32x4*)(wp + (size_t)k * ADA);
                        const f32x4 c0 = *(const LAS f32x4*)(cond + k * 8), c1 = *(const LAS f32x4*)(cond + k * 8 + 4);
#pragma unroll
                        for (int j = 0; j < 4; ++j) { acc[0][j] += c0[0] * w[j]; acc[1][j] += c0[1] * w[j]; acc[2][j] += c0[2] * w[j]; acc[3][j] += c0[3] * w[j];
                            acc[4][j] += c1[0] * w[j]; acc[5][j] += c1[1] * w[j]; acc[6][j] += c1[2] * w[j]; acc[7][j] += c1[3] * w[j]; }
                    }
                }
                __syncthreads();
                LAS float* part = (LAS float*)lds;
                if (kg < KG) {
#pragma unroll
                    for (int b = 0; b < 8; ++b) *(LAS f32x4*)(part + (kg * 8 + b) * SW + cq * 4) = (f32x4){acc[b][0], acc[b][1], acc[b][2], acc[b][3]};
                }
                __syncthreads();
                for (int o = tid; o < 8 * SW; o += 512) { const int b = o / SW, cc = o % SW; float s = adab[(size_t)l * ADA + col0 + cc];
                    for (int q = 0; q < KG; ++q) s += part[(q * 8 + b) * SW + cc];
                    mod[((size_t)l * BATCH + b) * ADA + col0 + cc] = s; }
                __syncthreads();
            }
        }
        {
            const int tid = fresh_tid(), lane = tid & 63, wave = __builtin_amdgcn_readfirstlane(tid >> 6), gw = vcu * 8 + wave, ngw = G * 8;
            LAS float* scr = (LAS float*)(lds + wave * 8448);
            constexpr int I_IN = 64 * (IN_W / 32), I_GT = 64 * (GATE_W / 32), I_BR = 64 * (D / 32), I_OUT = I_BR, I_FG = 64 * (FF / 32), I_FU = I_FG, I_FD = (FF / 64) * (D / 32), I_PW = 4 * 4 * 8;
            constexpr int PER_LAYER = I_IN + I_GT + I_BR + I_OUT + I_FG + I_FU + I_FD + I_PW;
            for (int it = gw; it < DEPTH * PER_LAYER; it += ngw) {
                const int l = it / PER_LAYER; int r = it - l * PER_LAYER;
                guc* wl = WLAYER(l);
                if (r < I_IN) { const int nb = r % (IN_W / 32), kb = r / (IN_W / 32);
                    transpose_item(INP(I_WIN) + (size_t)l * D * IN_W, IN_W, kb * 64, nb * 32, wl + W_1, nb * 32, D / 64, scr, lane); continue; } r -= I_IN;
                if (r < I_GT) { const int nb = r % (GATE_W / 32), kb = r / (GATE_W / 32);
                    transpose_item(INP(I_WGATE) + (size_t)l * D * GATE_W, GATE_W, kb * 64, nb * 32, wl + W_1, IN_W + nb * 32, D / 64, scr, lane); continue; } r -= I_GT;
                if (r < I_BR) { const int nb = r % (D / 32), kb = r / (D / 32);
                    transpose_item(INP(I_WBRANCH) + (size_t)l * D * D, D, kb * 64, nb * 32, wl + W_B, nb * 32, D / 64, scr, lane); continue; } r -= I_BR;
                if (r < I_OUT) { const int nb = r % (D / 32), kb = r / (D / 32);
                    transpose_item(INP(I_WOUT) + (size_t)l * D * D, D, kb * 64, nb * 32, wl + W_O, nb * 32, D / 64, scr, lane); continue; } r -= I_OUT;
                if (r < I_FG) { const int nb = r % (FF / 32), kb = r / (FF / 32); const int n0 = nb * 32, row = (n0 / 128) * 256 + (n0 % 128);
                    transpose_item(INP(I_FWG) + (size_t)l * D * FF, FF, kb * 64, n0, wl + W_F, row, D / 64, scr, lane); continue; } r -= I_FG;
                if (r < I_FU) { const int nb = r % (FF / 32), kb = r / (FF / 32); const int n0 = nb * 32, row = (n0 / 128) * 256 + 128 + (n0 % 128);
                    transpose_item(INP(I_FWU) + (size_t)l * D * FF, FF, kb * 64, n0, wl + W_F, row, D / 64, scr, lane); continue; } r -= I_FU;
                if (r < I_FD) { const int nb = r % (D / 32), kb = r / (D / 32);
                    transpose_item(INP(I_FWD) + (size_t)l * FF * D, D, kb * 64, nb * 32, wl + W_D, nb * 32, FF / 64, scr, lane); continue; } r -= I_FD;
                { const int gi = r / 32, rr = r % 32, nb = rr % 8, kb = rr / 8;
                    transpose_item(INP(I_POOLW) + ((size_t)l * 4 + gi) * 256 * 256, 256, kb * 64, nb * 32, WSB + WS_PWT + (size_t)l * 1024 * 256 * 2, gi * 256 + nb * 32, 4, scr, lane); }
            }
        }
    }
    SEAM(0);
    if (IN(1)) { GEOM(); const gfl* mod = MODP; rownorm_phase<false, true>(INP(I_X), (void GAS*)nullptr, (const gbf*)nullptr, (const gfl*)nullptr, (const gfl*)nullptr, INP(I_MPRE), mod + 0 * D, mod + 1 * D, HB, bx, G, lds); }
    SEAM(1);

#pragma nounroll
    for (int l = 0; l < DEPTH; ++l) {
        const int pb = 2 + 9 * l;
        if (IN(pb + 0)) {
            GEOM();
            typedef pg8::Prob<1, 0, 0, D / 64, 0, 0> PT; PT P{HB, (const gbf*)(WLAYER(l) + W_1), D / 64, D / 64, M / 256, N1 / 256, G, bx, 0, 0};
            pg8::EpiInGate E{PROJP, GATESP, INP(I_BGATE) + (size_t)l * GATE_W, (GAS unsigned*)(WSB + WS_CTL) + CW_NMAX + l * 1024};
            pg8::gemm_phase<pg8::EpiInGate, PT, true, true>(lds, P, E);
        }
        SEAM(pb + 0);
        const bool zlocal = (opq((int)gridDim.x) == (M / 256) * 4);
        if (IN(pb + 1) && !zlocal) {
            GEOM();
            const int tid = fresh_tid(); const gbf* proj = PROJP; gbf* zb = ZB;
            for (int it = (vcu * 512 + tid); it < M * 128; it += G * 512) {
                const int m = it >> 7, ch = it & 127, t = m % T, r = 1 << (ch >> 5);
                const int tlo = (t - r < 0) ? 0 : t - r, thi = (t + r + 1 > T) ? T : t + r + 1;
                const gbf* up = proj + (size_t)(m - t) * IN_W + OFF_U + ch * 8;
                float s[8];
#pragma unroll
                for (int j = 0; j < 8; ++j) s[j] = 0.f;
                u32x4 wv[17];
#pragma unroll
                for (int k = 0; k < 17; ++k) { const int q = t - 8 + k; const bool ok = (q >= tlo) && (q < thi); wv[k] = ok ? *(const GAS u32x4*)(up + (size_t)(ok ? q : t) * IN_W) : (u32x4){0u, 0u, 0u, 0u}; }
#pragma unroll
                for (int k = 0; k < 17; ++k) { const u32x4 w = wv[k];
                    s[0] += bf_lo(w.x); s[1] += bf_hi(w.x); s[2] += bf_lo(w.y); s[3] += bf_hi(w.y); s[4] += bf_lo(w.z); s[5] += bf_hi(w.z); s[6] += bf_lo(w.w); s[7] += bf_hi(w.w); }
                const u32x4 w = *(const GAS u32x4*)(up + (size_t)t * IN_W); const float ic = 1.0f / (float)(thi - tlo);
                u32x4 o; o.x = cvt_pk_bf16(s[0] * ic - bf_lo(w.x), s[1] * ic - bf_hi(w.x)); o.y = cvt_pk_bf16(s[2] * ic - bf_lo(w.y), s[3] * ic - bf_hi(w.y));
                o.z = cvt_pk_bf16(s[4] * ic - bf_lo(w.z), s[5] * ic - bf_hi(w.z)); o.w = cvt_pk_bf16(s[6] * ic - bf_lo(w.w), s[7] * ic - bf_hi(w.w));
                *(GAS u32x4*)((guc*)zb + pg8::atile_off(m, ch * 8, POOLW / 64)) = o;
            }
        }
        if (!zlocal) SEAM(pb + 1);
        if (IN(pb + 2)) {
            const float lam_init = (l == 0) ? 0.2f : (0.8f - 0.6f * 0.7408182206817179f);
            {
                GEOM();
                typedef pg8::Prob<1, 0, 0, 4, 0, 0> PT; PT P{ZB, (const gbf*)(WSB + WS_PWT) + (size_t)l * 1024 * 256, POOLW / 64, 4, M / 256, 4, G, bx, 256, 0};
                if (zlocal) {
                    pg8::Unit u0;
                    if (P.next(0, u0)) { const int tid = fresh_tid(), m0 = u0.pm * 256 + (tid >> 5) * 16, t0 = m0 % T, ch = u0.pn * 32 + (tid & 31);
                        const gbf* up = PROJP + (size_t)(m0 - t0) * IN_W + OFF_U + ch * 8; guc* zimg = (guc*)ZB;
                        if (u0.pn == 0) stencil_block<1>(up, t0, zimg, m0, ch); else if (u0.pn == 1) stencil_block<2>(up, t0, zimg, m0, ch);
                        else if (u0.pn == 2) stencil_block<4>(up, t0, zimg, m0, ch); else stencil_block<8>(up, t0, zimg, m0, ch); }
                    __syncthreads();
                }
                pg8::EpiPool E{MIXP, INP(I_PSCALE) + (size_t)l * POOLW};
                pg8::gemm_phase<pg8::EpiPool, PT, false, true>(lds, P, E);
            }
            {
                GEOM(); const gbf* proj = PROJP; gbf* mix = MIXP; const gfl* sinkp = INP(I_SINK) + l * 12;
                for (int u = vcu; u < BATCH * 12 * 16; u += G) {
                    const int qb = u & 15, hh = (u >> 4) % 12, b = u / (16 * 12);
                    const float slope2 = exp2f(-8.0f * (float)(hh + 1) / 12.0f) * LOG2E, sink2 = sinkp[hh] * LOG2E;
                    attn_unit<1>(lds, proj, mix, b, hh, qb, slope2, sink2, 0.f, (const gfl*)nullptr, 1.f);
                }
            }
            {
                GEOM(); const gbf* proj = PROJP; gbf* mix = MIXP; const gfl* subg = INP(I_SUBG) + (size_t)l * 128;
                const gfl* lv = INP(I_LAMBDA) + (size_t)l * 256; const int lane = fresh_tid() & 63;
                const float s1 = wave_sum(lv[lane] * lv[64 + lane]), s2 = wave_sum(lv[128 + lane] * lv[192 + lane]);
                const float lam = __expf(s1) - __expf(s2) + lam_init;
                for (int u = vcu; u < BATCH * 12 * 16; u += G) {
                    const int qb = u & 15, hh = (u >> 4) % 12, b = u / (16 * 12);
                    const float slope2 = exp2f(-8.0f * (float)(hh + 1) / 12.0f) * LOG2E;
                    const GAS unsigned* nm = (const GAS unsigned*)(WSB + WS_CTL) + CW_NMAX + l * 1024 + b * 48 + hh * 4;
                    const float q0 = 1.01f * (__uint_as_float(nm[0]) + __uint_as_float(nm[1])), q1 = 1.01f * (__uint_as_float(nm[2]) + __uint_as_float(nm[3]));
                    const float k0 = 1.01f * (__uint_as_float(nm[BATCH * 48]) + __uint_as_float(nm[BATCH * 48 + 1])), k1 = 1.01f * (__uint_as_float(nm[BATCH * 48 + 2]) + __uint_as_float(nm[BATCH * 48 + 3]));
                    const float bound = 0.125f * LOG2E * sqrtf(fmaxf(q0 * k0, q1 * k1));
                    if (bound <= 60.0f) attn_c_fast(lds, proj, mix, b, hh, qb, slope2, lam, subg, 1.0f - lam_init, k0, k1);
                    else attn_unit<2>(lds, proj, mix, b, hh, qb, slope2, 0.f, lam, subg, 1.0f - lam_init);
                }
            }
        }
        SEAM(pb + 2);
        if (IN(pb + 3)) {
            GEOM();
            typedef pg8::Prob<3, MIX_B, MIX_C, 1536 / 64, 1024 / 64, 1536 / 64> PT; PT P{MIXP, (const gbf*)(WLAYER(l) + W_B), D / 64, D / 64, M / 256, D / 256, G, bx, 0, 1};
            pg8::EpiBranch E{GATESP, MERGP};
            pg8::gemm_phase<pg8::EpiBranch, PT, true, true>(lds, P, E);
        }
        SEAM(pb + 3);
        if (IN(pb + 4)) {
            GEOM();
            typedef pg8::Prob<1, 0, 0, D / 64, 0, 0> PT; PT P{MERGP, (const gbf*)(WLAYER(l) + W_O), D / 64, D / 64, M / 256, D / 256, G, bx, 0, 0};
            pg8::EpiStore E{YB, D};
            pg8::gemm_phase<pg8::EpiStore, PT, true, true>(lds, P, E);
        }
        SEAM(pb + 4);
        if (IN(pb + 5)) { GEOM(); const gfl* modl = MODP + (size_t)l * BATCH * ADA;
            if (l == 0) rownorm_phase<false, true>(INP(I_X), XBP, YB, INP(I_MPOST) + (size_t)l * D, modl + 2 * D, INP(I_FPRE) + (size_t)l * D, modl + 3 * D, modl + 4 * D, HB, bx, G, lds);
            else rownorm_phase<true, true>(XBP, XBP, YB, INP(I_MPOST) + (size_t)l * D, modl + 2 * D, INP(I_FPRE) + (size_t)l * D, modl + 3 * D, modl + 4 * D, HB, bx, G, lds); }
        SEAM(pb + 5);
        if (IN(pb + 6)) {
            GEOM();
            typedef pg8::Prob<1, 0, 0, D / 64, 0, 0> PT; PT P{HB, (const gbf*)(WLAYER(l) + W_F), D / 64, D / 64, M / 256, NF / 256, G, bx, 0, 0};
            pg8::EpiSwiglu E{HIDP};
            pg8::gemm_phase<pg8::EpiSwiglu, PT, true, true>(lds, P, E);
        }
        SEAM(pb + 6);
        if (IN(pb + 7)) {
            GEOM();
            typedef pg8::Prob<1, 0, 0, FF / 64, 0, 0> PT; PT P{HIDP, (const gbf*)(WLAYER(l) + W_D), FF / 64, FF / 64, M / 256, D / 256, G, bx, 0, 0};
            pg8::EpiStore E{YB, D};
            pg8::gemm_phase<pg8::EpiStore, PT, true, true>(lds, P, E);
        }
        SEAM(pb + 7);
        if (IN(pb + 8)) {
            GEOM(); const gfl* modl = MODP + (size_t)l * BATCH * ADA;
            const bool more = (l + 1 < DEPTH); const int ln = more ? l + 1 : l; const gfl* modn = MODP + (size_t)ln * BATCH * ADA;
            if (more) rownorm_phase<true, true>(XBP, XBP, YB, INP(I_FPOST) + (size_t)l * D, modl + 5 * D, INP(I_MPRE) + (size_t)ln * D, modn + 0 * D, modn + 1 * D, HB, bx, G, lds);
            else rownorm_phase<true, false>(XBP, (gfl*)a.out, YB, INP(I_FPOST) + (size_t)l * D, modl + 5 * D, INP(I_MPRE) + (size_t)ln * D, modn + 0 * D, modn + 1 * D, (gbf*)nullptr, bx, G, lds);
        }
        SEAM(pb + 8);
    }
#undef IN
#undef SEAM
}


constexpr int N_PHASES = 2 + 9 * DEPTH;
extern "C" void kernel_launch(void* const* d_in, const int* in_sizes, int n_in, void* d_out, int out_size, void* d_ws, size_t ws_size, hipStream_t stream) {
    static int grid = 0;
    if (grid == 0) {
        if (n_in != 21 || in_sizes[0] != M * D || out_size != M * D || ws_size < WS_END) { fprintf(stderr, "kernel_launch: unexpected shapes (n_in %d, in0 %d, out %d, ws %zu < %zu)\n", n_in, n_in > 0 ? in_sizes[0] : -1, out_size, ws_size, (size_t)WS_END); grid = -1; return; }
        int dev = 0, cus = 0, per_cu = 0;
        if (hipGetDevice(&dev) != hipSuccess || hipDeviceGetAttribute(&cus, hipDeviceAttributeMultiprocessorCount, dev) != hipSuccess) { grid = -1; return; }
        if (hipFuncSetAttribute((const void*)fwd, hipFuncAttributeMaxDynamicSharedMemorySize, LDS_BYTES) != hipSuccess) { fprintf(stderr, "kernel_launch: hipFuncSetAttribute failed\n"); grid = -1; return; }
        if (hipOccupancyMaxActiveBlocksPerMultiprocessor(&per_cu, (const void*)fwd, 512, LDS_BYTES) != hipSuccess || per_cu < 1) fprintf(stderr, "kernel_launch: occupancy query reports %d\n", per_cu);
        (void)hipGetLastError();
        grid = cus;
    }
    if (grid < 0) return;
    if (hipMemsetAsync((char*)d_ws + WS_CTL, 0, CTL_ZERO_BYTES, stream) != hipSuccess) return;
    Args a{};
    for (int i = 0; i < 21; ++i) a.in[i] = (const float*)d_in[i];
    a.out = (float*)d_out; a.ws = (unsigned char*)d_ws;
#if MK_N_LAUNCHES == 1
    a.ph_lo = 0; a.ph_hi = N_PHASES;
    hipLaunchKernelGGL(fwd, dim3(grid), dim3(512), LDS_BYTES, stream, a);
#else
    for (int p = 0; p < N_PHASES; ++p) { a.ph_lo = p; a.ph_hi = p + 1; hipLaunchKernelGGL(fwd, dim3(grid), dim3(512), LDS_BYTES, stream, a); }
#endif
}
```

```cpp
#include <hip/hip_runtime.h>
#include <cstdio>
#include <cstdint>

#ifndef MK_N_LAUNCHES
#define MK_N_LAUNCHES 1
#endif

#define LAS __attribute__((address_space(3)))
#define GAS __attribute__((address_space(1)))
typedef unsigned short bf16_t;
typedef short bf16x8 __attribute__((ext_vector_type(8)));
typedef short s16x4 __attribute__((ext_vector_type(4)));
typedef float f32x4 __attribute__((ext_vector_type(4)));
typedef float f32x2 __attribute__((ext_vector_type(2)));
typedef unsigned u32x4 __attribute__((ext_vector_type(4)));
typedef unsigned u32x2 __attribute__((ext_vector_type(2)));
typedef GAS bf16_t gbf;
typedef GAS float gfl;
typedef GAS unsigned char guc;

constexpr int D = 4096, BATCH = 8, T = 2048, DEPTH = 2, M = BATCH * T;
constexpr int IN_W = 8192, GATE_W = 12288, N1 = IN_W + GATE_W;
constexpr int FF = 11008, NF = 2 * FF;
constexpr int ADA = 6 * D;
constexpr int OFF_QA = 0, OFF_KA = 1536, OFF_VA = 2048, OFF_U = 2560, OFF_QC = 3584, OFF_KC = 5120, OFF_VC = 6656;
constexpr int MIX_B = 1536, MIX_C = 2560;
constexpr int POOLW = 1024;
constexpr float NORM_EPS = 1e-6f, SUBLN_EPS = 1e-5f;
constexpr float LOG2E = 1.4426950408889634f;

constexpr size_t MiB = 1u << 20;
constexpr size_t WS_CTL = 0, CTL_ZERO_BYTES = 1 * MiB;
constexpr size_t WS_MOD = 1 * MiB;
constexpr size_t WS_PWT = 3 * MiB;
constexpr size_t WS_W = 4 * MiB, W_LAYER = 482 * MiB;
constexpr size_t W_1 = 0, W_B = 160 * MiB, W_O = 192 * MiB, W_F = 224 * MiB, W_D = 396 * MiB;
constexpr size_t WS_H = 968 * MiB, WS_MIX = 1096 * MiB, WS_MERG = 1224 * MiB, WS_Y = 1352 * MiB, WS_M32 = 1480 * MiB, WS_Z = 1736 * MiB;
constexpr size_t WS_PROJ = 1768 * MiB, WS_GATES = 2024 * MiB, WS_HID = WS_PROJ, WS_END = 2408 * MiB;
static_assert(WS_W + 2 * W_LAYER == WS_H, "ws map");
static_assert((size_t)M * FF * 2 <= WS_END - WS_HID, "hid overlay");
constexpr int CW_TMO = 0, CW_BAR = 4096, CW_NMAX = 32768;

constexpr int RING_BYTES = 131072;
constexpr int LDSCTL_OFF = RING_BYTES, MISC_OFF = LDSCTL_OFF + 320;
constexpr int LDS_BYTES = 147456;

#define LDS_WAIT() asm volatile("s_waitcnt lgkmcnt(0)" ::: "memory")
#define VM_WAIT() asm volatile("s_waitcnt vmcnt(0)" ::: "memory")

typedef float f32x2_t __attribute__((ext_vector_type(2))); typedef __bf16 bf16x2_t __attribute__((ext_vector_type(2)));
__device__ __forceinline__ unsigned cvt_pk_bf16(float lo, float hi) { f32x2_t v = {lo, hi}; bf16x2_t b = __builtin_convertvector(v, bf16x2_t); return __builtin_bit_cast(unsigned, b); }
__device__ __forceinline__ float bf_lo(unsigned w) { return __uint_as_float(w << 16); }
__device__ __forceinline__ float bf_hi(unsigned w) { return __uint_as_float(w & 0xffff0000u); }
__device__ __forceinline__ float wave_sum(float v) {
#pragma unroll
    for (int o = 1; o < 64; o <<= 1) v += __shfl_xor(v, o);
    return v;
}
__device__ __forceinline__ int opq(int k) { asm volatile("" : "+s"(k)); return k; }
template <class TP> __device__ __forceinline__ TP* opqp(TP* p) { asm volatile("" : "+s"(p)); return p; }
__device__ __forceinline__ int fresh_tid() { int t = threadIdx.x; asm volatile("" : "+v"(t)); return t; }
__device__ __forceinline__ float fast_sigmoid(float x) { return __builtin_amdgcn_rcpf(1.0f + __builtin_amdgcn_exp2f(-x * LOG2E)); }

#define XB_TMO      128
#define XB_XCNT(j)  (256  + 64 * (j))
#define XB_XSUB(j)  (1280 + 64 * (j))
#define XB_XGEN(j)  (2304 + 64 * (j))
#define XB_TOP      3328
#define XB_TOPGEN   3392
#define XCD_BAR_WORDS 3456
#define XB_SPIN_CAP (1u << 18)
__device__ __forceinline__ unsigned xb_ld(unsigned* p)              { return __hip_atomic_load(p, __ATOMIC_RELAXED, __HIP_MEMORY_SCOPE_AGENT); }
__device__ __forceinline__ unsigned xb_add(unsigned* p, unsigned v) { return __hip_atomic_fetch_add(p, v, __ATOMIC_RELAXED, __HIP_MEMORY_SCOPE_AGENT); }
__device__ __forceinline__ unsigned xb_xcc_id() { return (unsigned)__builtin_amdgcn_s_getreg((3 << 11) | 20) & 0xFu; }
#define XB_SPIN(cond, bar) do { unsigned _sp = 0; while (cond) { __builtin_amdgcn_s_sleep(1); \
    if ((++_sp & 255u) == 0u) { if (xb_ld(&(bar)[XB_TMO])) break; if (_sp > XB_SPIN_CAP) { atomicAdd(&(bar)[XB_TMO], 1u); break; } } } } while (0)
struct XcdBarrier { unsigned* bar; unsigned x; volatile LAS unsigned* st; };
__device__ __forceinline__ XcdBarrier xcd_barrier_post(unsigned* bar, volatile LAS unsigned* st) {
    XcdBarrier b; b.bar = bar; b.x = xb_xcc_id(); b.st = st;
    if (threadIdx.x == 0) (void)xb_add(&bar[XB_XCNT(b.x)], 1u);
    return b;
}
__device__ __forceinline__ void xcd_barrier_complete(unsigned* bar, unsigned x, unsigned& nloc, unsigned& nx) {
    const unsigned G = gridDim.x * gridDim.y * gridDim.z;
    unsigned sum, cnt, mine, sp = 0u;
    for (;;) {
        sum = 0u; cnt = 0u; mine = 0u;
#pragma unroll
        for (unsigned j = 0; j < 16; ++j) { const unsigned c = xb_ld(&bar[XB_XCNT(j)]); sum += c; cnt += (c > 0u) ? 1u : 0u; mine = (j == x) ? c : mine; }
        if (sum == G) break;
        __builtin_amdgcn_s_sleep(1);
        if ((++sp & 255u) == 0u) { if (xb_ld(&bar[XB_TMO])) break; if (sp > XB_SPIN_CAP) { atomicAdd(&bar[XB_TMO], 1u); break; } }
    }
    nloc = mine > 0u ? mine : 1u; nx = cnt > 0u ? cnt : 1u;
}
__device__ __forceinline__ void xcd_barrier(const XcdBarrier& b) {
    asm volatile("s_waitcnt vmcnt(0)" ::: "memory");
    __syncthreads();
    if (threadIdx.x == 0) {
        unsigned* bar = b.bar;
        __builtin_amdgcn_s_waitcnt(0);
        unsigned nloc = b.st[0], nx = b.st[1];
        if (nloc == 0u) { xcd_barrier_complete(bar, b.x, nloc, nx); b.st[0] = nloc; b.st[1] = nx; }
        const unsigned old = xb_add(&bar[XB_XSUB(b.x)], 1u);
        const unsigned gen = old / nloc;
        if (old + 1u == (gen + 1u) * nloc) {
            __builtin_amdgcn_fence(__ATOMIC_RELEASE, "agent");
            asm volatile("s_waitcnt vmcnt(0)" ::: "memory");
            const unsigned og = xb_add(&bar[XB_TOP], 1u);
            const unsigned tg = og / nx;
            if (og + 1u == (tg + 1u) * nx) xb_add(&bar[XB_TOPGEN], 1u);
            else XB_SPIN(xb_ld(&bar[XB_TOPGEN]) == tg, bar);
            __builtin_amdgcn_fence(__ATOMIC_ACQUIRE, "agent");
            xb_add(&bar[XB_XGEN(b.x)], 1u);
            asm volatile("s_waitcnt vmcnt(0)" ::: "memory");
        } else {
            XB_SPIN(xb_ld(&bar[XB_XGEN(b.x)]) == gen, bar);
            __builtin_amdgcn_fence(__ATOMIC_ACQUIRE, "agent");
            asm volatile("s_waitcnt vmcnt(0)" ::: "memory");
        }
    }
    __syncthreads();
}

namespace pg8 {
constexpr int BM = 256, BK = 64, HALF = 128, HTB = HALF * BK * 2, STAGE_BYTES = 8 * HTB, NXCD = 8, WGM = 8;
__host__ __device__ __forceinline__ int lds_byte(int r, int c) { const int st = (r >> 4) * 2 + (c >> 5), rr = r & 15, cc = c & 31, ob = rr * 64 + cc * 2; return st * 1024 + (ob ^ (((ob >> 9) & 1) << 5)); }
__host__ __device__ __forceinline__ void stage_rc(int b, int& R, int& C) { const int st = b / 1024, sb = b % 1024, swz = sb ^ (((sb >> 9) & 1) << 5); R = (st >> 1) * 16 + swz / 64; C = (st & 1) * 32 + (swz % 64) / 2; }
__host__ __device__ __forceinline__ int perm32(int rho) { const int n = rho >> 4, i = rho & 15; return 8 * (i >> 2) + 4 * n + (i & 3); }

__host__ __device__ __forceinline__ size_t btile_off(int r, int kt, int c8, int nkt) {
    const int pn = r >> 8, half = (r >> 7) & 1, rl = r & 127, q = rl & 31, rho = (rl & ~31) + 16 * ((q >> 2) & 1) + 4 * (q >> 3) + (q & 3);
    return ((size_t)pn * nkt + kt) * (size_t)(2 * HTB) + (size_t)half * HTB + lds_byte(rho, 8 * c8);
}
__host__ __device__ __forceinline__ size_t atile_off(int r, int k, int nkt) {
    return ((size_t)(r >> 8) * nkt + (k >> 6)) * (size_t)(2 * HTB) + (size_t)((r >> 7) & 1) * HTB + lds_byte(r & 127, k & 56) + (k & 7) * 2;
}
struct Unit { int pm, pn, seg; };
template <int NSEG, int AK1, int AK2, int NT0, int NT1, int NT2>
struct Prob {
    const gbf* A; const gbf* B; int lda, ldb;
    int nM, nN, G, c, apn, bshare;
    __device__ __forceinline__ bool next(int i, Unit& u) const {
        const int nwg = nM * nN; if (c >= nwg) return false;
        const int nr = (nwg - c + G - 1) / G;
        int seg = 0, j = i;
        if constexpr (NSEG > 1) { j = i / NSEG; seg = i - j * NSEG; }
        if (j >= nr) return false;
        int wgid = j * G + c; { const int q = nwg / NXCD, r = nwg % NXCD, xcd = wgid % NXCD, off = wgid / NXCD; wgid = (xcd < r ? xcd * (q + 1) : r * (q + 1) + (xcd - r) * q) + off; }
        const int nig = WGM * nN, gid = wgid / nig, fm = gid * WGM, gsz = (nM - fm) < WGM ? (nM - fm) : WGM;
        u.pm = fm + ((wgid % nig) % gsz); u.pn = (wgid % nig) / gsz; u.seg = seg; return true;
    }
    __device__ __forceinline__ int nt(const Unit& u) const { if constexpr (NSEG == 1) return NT0; else return u.seg == 0 ? NT0 : (u.seg == 1 ? NT1 : NT2); }
    __device__ __forceinline__ int ak(const Unit& u) const { if constexpr (NSEG == 1) return 0; else return u.seg == 0 ? 0 : (u.seg == 1 ? AK1 : AK2); }
    __device__ __forceinline__ const GAS char* a_ptr(const Unit& u) const { return (const GAS char*)A + ((size_t)u.pm * lda + (ak(u) + u.pn * apn) / BK) * (size_t)(2 * HTB); }
    __device__ __forceinline__ const GAS char* b_ptr(const Unit& u) const { return (const GAS char*)B + ((size_t)u.pn * ldb + (bshare ? ak(u) / BK : 0)) * (size_t)(2 * HTB); }
};

template <class Epi, class ProbT, bool ALIGN_EPI, bool SP2>
__device__ __forceinline__ void gemm_phase(LAS unsigned char* lds, const ProbT& P, const Epi& E) {
    const int tid = fresh_tid(), wid = __builtin_amdgcn_readfirstlane(tid >> 6), lane = tid & 63, wr = wid >> 2, wc = wid & 3, fr = lane & 15, fq = lane >> 4;
    unsigned voffA[2], voffB[2];
#pragma unroll
    for (int i = 0; i < 2; ++i) { int R, C; stage_rc(tid * 16 + i * 8192, R, C); const int Rb = (R & ~31) + perm32(R & 31);
        voffA[i] = (unsigned)(tid * 16 + i * 8192); voffB[i] = voffA[i]; (void)Rb; (void)R; (void)C; }
    const size_t kstepB = (size_t)(2 * HTB), kstep = kstepB;
    const size_t hstepA = (size_t)HTB, hstepB = (size_t)HTB;
    const unsigned ldsw = (unsigned)wid * 1024u;
    const int aoff = lds_byte(wr * 64 + fr, fq * 8), boff = lds_byte(wc * 32 + fr, fq * 8);
#define PG8_SA(b, h) (((b) * 2 + (h)) * HTB)
#define PG8_SB(b, h) ((4 + (b) * 2 + (h)) * HTB)
#define PG8_STAGE(bufoff, gbase, voff) do { _Pragma("unroll") for (int _i = 0; _i < 2; ++_i) \
        __builtin_amdgcn_global_load_lds((const GAS unsigned*)((const GAS char*)(gbase) + (voff)[_i]), (LAS unsigned*)(lds + (bufoff) + ldsw + _i * 8192), 16, 0, 0); } while (0)
#define PG8_LDA(dst, b, h) do { _Pragma("unroll") for (int m = 0; m < 4; ++m) _Pragma("unroll") for (int k = 0; k < 2; ++k) dst[m][k] = *(const LAS bf16x8*)(lds + PG8_SA(b, h) + aoff + m * 2048 + k * 1024); } while (0)
#define PG8_LDB(dst, b, h) do { _Pragma("unroll") for (int n = 0; n < 2; ++n) _Pragma("unroll") for (int k = 0; k < 2; ++k) dst[n][k] = *(const LAS bf16x8*)(lds + PG8_SB(b, h) + boff + n * 2048 + k * 1024); } while (0)
#define PG8_MMA(ai, bj, At, Bt) do { __builtin_amdgcn_s_setprio(1); _Pragma("unroll") for (int m = 0; m < 4; ++m) _Pragma("unroll") for (int n = 0; n < 2; ++n) _Pragma("unroll") for (int k = 0; k < 2; ++k) \
        acc[ai][bj][m][n] = __builtin_amdgcn_mfma_f32_16x16x32_bf16(Bt[n][k], At[m][k], acc[ai][bj][m][n], 0, 0, 0); __builtin_amdgcn_s_setprio(0); } while (0)
#define PG8_WAIT_V(n) asm volatile("s_waitcnt vmcnt(" #n ")" ::: "memory")
#define PG8_WAIT_L(n) asm volatile("s_waitcnt lgkmcnt(" #n ")" ::: "memory")
#define PG8_BAR __builtin_amdgcn_s_barrier()
#define PG8_SCHED __builtin_amdgcn_sched_barrier(0)
    Unit cur, nxt; int ui = 0;
    if (!P.next(0, cur)) return;
    f32x4 acc[2][2][4][2];
#pragma unroll
    for (int a = 0; a < 2; ++a)
#pragma unroll
        for (int b = 0; b < 2; ++b)
#pragma unroll
            for (int m = 0; m < 4; ++m)
#pragma unroll
                for (int n = 0; n < 2; ++n) acc[a][b][m][n] = (f32x4){0.f, 0.f, 0.f, 0.f};
    bf16x8 At[4][2], B0[2][2], B1[2][2];
    const GAS char* cA = P.a_ptr(cur); const GAS char* cB = P.b_ptr(cur); int nt = P.nt(cur);
    if constexpr (SP2) {
        PG8_STAGE(PG8_SB(0, 0), cB, voffB); PG8_STAGE(PG8_SB(0, 1), cB + hstepB, voffB); PG8_STAGE(PG8_SA(0, 0), cA, voffA); PG8_STAGE(PG8_SA(0, 1), cA + hstepA, voffA);
        if (wr == 1) PG8_BAR;
        PG8_WAIT_V(2); PG8_BAR;
        PG8_STAGE(PG8_SB(1, 0), cB + kstepB, voffB); PG8_STAGE(PG8_SA(1, 0), cA + kstep, voffA); PG8_STAGE(PG8_SB(1, 1), cB + hstepB + kstepB, voffB);
        PG8_WAIT_V(6); PG8_BAR;
    } else {
        PG8_STAGE(PG8_SB(0, 0), cB, voffB); PG8_STAGE(PG8_SA(0, 0), cA, voffA); PG8_STAGE(PG8_SB(0, 1), cB + hstepB, voffB); PG8_STAGE(PG8_SA(0, 1), cA + hstepA, voffA);
        if (wr == 1) PG8_BAR;
        PG8_WAIT_V(4); PG8_BAR;
        PG8_STAGE(PG8_SB(1, 0), cB + kstepB, voffB); PG8_STAGE(PG8_SA(1, 0), cA + kstep, voffA); PG8_STAGE(PG8_SB(1, 1), cB + hstepB + kstepB, voffB);
        PG8_WAIT_V(6); PG8_BAR;
    }
    for (;;) {
        const bool has_next = P.next(ui + 1, nxt);
        const GAS char* nA = has_next ? P.a_ptr(nxt) : cA; const GAS char* nB = has_next ? P.b_ptr(nxt) : cB;
#pragma nounroll
        for (int t = 0; t < nt; t += 2) {
            const bool last = (t == nt - 2);
            const GAS char* a1 = cA + (size_t)(t + 1) * kstep;
            const GAS char* a2 = last ? nA : cA + (size_t)(t + 2) * kstep; const GAS char* b2 = last ? nB : cB + (size_t)(t + 2) * kstepB;
            const GAS char* a3 = a2 + kstep; const GAS char* b3 = b2 + kstepB;
            if constexpr (SP2) {
            PG8_LDB(B0, 0, 0); PG8_LDB(B1, 0, 1); PG8_SCHED; PG8_LDA(At, 0, 0); PG8_STAGE(PG8_SA(1, 1), a1 + hstepA, voffA);
            PG8_WAIT_V(8); PG8_WAIT_L(0); PG8_BAR; PG8_MMA(0, 0, At, B0); PG8_MMA(0, 1, At, B1); PG8_BAR; PG8_SCHED;
            PG8_LDA(At, 0, 1); PG8_STAGE(PG8_SB(0, 0), b2, voffB); PG8_STAGE(PG8_SB(0, 1), b2 + hstepB, voffB); PG8_STAGE(PG8_SA(0, 0), a2, voffA);
            PG8_WAIT_V(8); PG8_WAIT_L(0); PG8_BAR; PG8_MMA(1, 0, At, B0); PG8_MMA(1, 1, At, B1); PG8_BAR; PG8_SCHED;
            PG8_LDB(B0, 1, 0); PG8_LDB(B1, 1, 1); PG8_SCHED; PG8_LDA(At, 1, 0); PG8_STAGE(PG8_SA(0, 1), a2 + hstepA, voffA);
            PG8_WAIT_V(8); PG8_WAIT_L(0); PG8_BAR; PG8_MMA(0, 0, At, B0); PG8_MMA(0, 1, At, B1); PG8_BAR; PG8_SCHED;
            PG8_LDA(At, 1, 1); PG8_STAGE(PG8_SB(1, 0), b3, voffB); PG8_STAGE(PG8_SB(1, 1), b3 + hstepB, voffB); PG8_STAGE(PG8_SA(1, 0), a3, voffA);
            PG8_WAIT_V(8); PG8_WAIT_L(0); PG8_BAR; PG8_MMA(1, 0, At, B0); PG8_MMA(1, 1, At, B1); PG8_BAR; PG8_SCHED;
            } else {
            PG8_LDB(B0, 0, 0); PG8_SCHED; PG8_LDA(At, 0, 0); PG8_STAGE(PG8_SA(1, 1), a1 + hstepA, voffA);
            PG8_WAIT_L(8); PG8_BAR; PG8_WAIT_L(0); PG8_MMA(0, 0, At, B0); PG8_BAR; PG8_SCHED;
            PG8_LDB(B1, 0, 1); PG8_STAGE(PG8_SB(0, 0), b2, voffB);
            PG8_BAR; PG8_WAIT_L(0); PG8_MMA(0, 1, At, B1); PG8_BAR;
            PG8_LDA(At, 0, 1); PG8_STAGE(PG8_SA(0, 0), a2, voffA);
            PG8_BAR; PG8_WAIT_L(0); PG8_MMA(1, 0, At, B0); PG8_BAR; PG8_SCHED;
            PG8_STAGE(PG8_SB(0, 1), b2 + hstepB, voffB);
            PG8_WAIT_V(6); PG8_BAR; PG8_MMA(1, 1, At, B1); PG8_BAR;
            PG8_LDB(B0, 1, 0); PG8_SCHED; PG8_LDA(At, 1, 0); PG8_STAGE(PG8_SA(0, 1), a2 + hstepA, voffA);
            PG8_WAIT_L(8); PG8_BAR; PG8_WAIT_L(0); PG8_MMA(0, 0, At, B0); PG8_BAR; PG8_SCHED;
            PG8_LDB(B1, 1, 1); PG8_STAGE(PG8_SB(1, 0), b3, voffB);
            PG8_BAR; PG8_WAIT_L(0); PG8_MMA(0, 1, At, B1); PG8_BAR;
            PG8_LDA(At, 1, 1); PG8_STAGE(PG8_SA(1, 0), a3, voffA);
            PG8_BAR; PG8_WAIT_L(0); PG8_MMA(1, 0, At, B0); PG8_BAR; PG8_SCHED;
            PG8_STAGE(PG8_SB(1, 1), b3 + hstepB, voffB);
            PG8_WAIT_V(6); PG8_BAR; PG8_MMA(1, 1, At, B1); PG8_BAR;
            }
        }
        if constexpr (ALIGN_EPI) { if (wr == 0) PG8_BAR; }
        E(acc, cur, wr, wc, fr, fq);
        if (!has_next) break;
        if (!E.keep(cur)) {
#pragma unroll
        for (int a = 0; a < 2; ++a)
#pragma unroll
            for (int b = 0; b < 2; ++b)
#pragma unroll
                for (int m = 0; m < 4; ++m)
#pragma unroll
                    for (int n = 0; n < 2; ++n) acc[a][b][m][n] = (f32x4){0.f, 0.f, 0.f, 0.f};
        }
        cur = nxt; cA = nA; cB = nB; nt = P.nt(cur); ++ui;
        if constexpr (ALIGN_EPI) { if (wr == 1) PG8_BAR; }
    }
    PG8_WAIT_V(0);
    if constexpr (!ALIGN_EPI) { if (wr == 0) PG8_BAR; }
    PG8_BAR;
#undef PG8_SA
#undef PG8_SB
#undef PG8_STAGE
#undef PG8_LDA
#undef PG8_LDB
#undef PG8_MMA
#undef PG8_WAIT_V
#undef PG8_WAIT_L
#undef PG8_BAR
#undef PG8_SCHED
}

__device__ __forceinline__ u32x4 pack8(const f32x4 v0, const f32x4 v1) { u32x4 w; w.x = cvt_pk_bf16(v0[0], v0[1]); w.y = cvt_pk_bf16(v0[2], v0[3]); w.z = cvt_pk_bf16(v1[0], v1[1]); w.w = cvt_pk_bf16(v1[2], v1[3]); return w; }

struct EpiInGate {
    __device__ __forceinline__ bool keep(const Unit&) const { return false; }
    gbf* proj; gbf* gates; const gfl* bgate; GAS unsigned* nmax;
    __device__ __forceinline__ void operator()(const f32x4 (&acc)[2][2][4][2], const Unit& u, int wr, int wc, int fr, int fq) const {
        const int row0 = u.pm * BM + wr * 64 + fr;
        if (u.pn < IN_W / BM) {
            const int col0 = u.pn * BM + wc * 32 + 8 * fq;
            if (u.pn >= OFF_QC / BM && u.pn < OFF_VC / BM) {
#pragma unroll
                for (int bj = 0; bj < 2; ++bj) {
                    float mx = 0.f;
#pragma unroll
                    for (int ai = 0; ai < 2; ++ai)
#pragma unroll
                        for (int m = 0; m < 4; ++m) { const f32x4 a = acc[ai][bj][m][0], e = acc[ai][bj][m][1];
                            float ss = (a[0] * a[0] + a[1] * a[1]) + (a[2] * a[2] + a[3] * a[3]) + (e[0] * e[0] + e[1] * e[1]) + (e[2] * e[2] + e[3] * e[3]);
                            ss += __shfl_xor(ss, 16); ss += __shfl_xor(ss, 32); mx = fmaxf(mx, ss); }
                    mx = fmaxf(mx, __shfl_xor(mx, 1)); mx = fmaxf(mx, __shfl_xor(mx, 2)); mx = fmaxf(mx, __shfl_xor(mx, 4)); mx = fmaxf(mx, __shfl_xor(mx, 8));
                    const int cq = u.pn * BM + bj * HALF + wc * 32 - OFF_QC;
                    const int qk = cq >= (OFF_KC - OFF_QC) ? 1 : 0, g32 = (cq - qk * (OFF_KC - OFF_QC)) >> 5, bb = (u.pm * BM) / T;
                    if (fr == 0 && fq == 0) __hip_atomic_fetch_max(nmax + (qk * BATCH + bb) * 48 + g32, __float_as_uint(mx), __ATOMIC_RELAXED, __HIP_MEMORY_SCOPE_AGENT);
                }
            }
#pragma unroll
            for (int ai = 0; ai < 2; ++ai)
#pragma unroll
                for (int m = 0; m < 4; ++m) { gbf* rowp = proj + (size_t)(row0 + ai * HALF + m * 16) * IN_W + col0;
#pragma unroll
                    for (int bj = 0; bj < 2; ++bj) *(GAS u32x4*)(rowp + bj * HALF) = pack8(acc[ai][bj][m][0], acc[ai][bj][m][1]); }
        } else {
            const int col0 = (u.pn - IN_W / BM) * BM + wc * 32 + 8 * fq;
            f32x4 bv[2][2];
#pragma unroll
            for (int bj = 0; bj < 2; ++bj)
#pragma unroll
                for (int n = 0; n < 2; ++n) bv[bj][n] = *(const GAS f32x4*)(bgate + col0 + bj * HALF + 4 * n);
#pragma unroll
            for (int ai = 0; ai < 2; ++ai)
#pragma unroll
                for (int m = 0; m < 4; ++m) {
#pragma unroll
                    for (int bj = 0; bj < 2; ++bj) { f32x4 v0 = acc[ai][bj][m][0] + bv[bj][0], v1 = acc[ai][bj][m][1] + bv[bj][1];
#pragma unroll
                        for (int j = 0; j < 4; ++j) { v0[j] = fast_sigmoid(v0[j]); v1[j] = fast_sigmoid(v1[j]); }
                        *(GAS u32x4*)((guc*)gates + atile_off(row0 + ai * HALF + m * 16, col0 + bj * HALF, GATE_W / BK)) = pack8(v0, v1); } }
        }
    }
};
struct EpiPool {
    __device__ __forceinline__ bool keep(const Unit&) const { return false; }
    gbf* mix; const gfl* pscale;
    __device__ __forceinline__ void operator()(const f32x4 (&acc)[2][2][4][2], const Unit& u, int wr, int wc, int fr, int fq) const {
        const int row0 = u.pm * BM + wr * 64 + fr, col0 = u.pn * BM + wc * 32 + 8 * fq;
        f32x4 sv[2][2];
#pragma unroll
        for (int bj = 0; bj < 2; ++bj)
#pragma unroll
            for (int n = 0; n < 2; ++n) sv[bj][n] = *(const GAS f32x4*)(pscale + col0 + bj * HALF + 4 * n);
#pragma unroll
        for (int ai = 0; ai < 2; ++ai)
#pragma unroll
            for (int m = 0; m < 4; ++m) {
#pragma unroll
                for (int bj = 0; bj < 2; ++bj) *(GAS u32x4*)((guc*)mix + atile_off(row0 + ai * HALF + m * 16, MIX_B + col0 + bj * HALF, D / BK)) = pack8(acc[ai][bj][m][0] * sv[bj][0], acc[ai][bj][m][1] * sv[bj][1]); }
    }
};
struct EpiBranch {
    const gbf* gates; gbf* merged;
    __device__ __forceinline__ bool keep(const Unit& u) const { return u.seg < 2; }
    __device__ __forceinline__ static void unpack(const u32x4 w, f32x4& lo, f32x4& hi) { lo = (f32x4){bf_lo(w.x), bf_hi(w.x), bf_lo(w.y), bf_hi(w.y)}; hi = (f32x4){bf_lo(w.z), bf_hi(w.z), bf_lo(w.w), bf_hi(w.w)}; }
    __device__ __forceinline__ void operator()(f32x4 (&acc)[2][2][4][2], const Unit& u, int wr, int wc, int fr, int fq) const {
        const int row0 = u.pm * BM + wr * 64 + fr, col0 = u.pn * BM + wc * 32 + 8 * fq;
        const guc* gimg = (const guc*)gates; const int gcol = u.seg * D + col0;
        if (u.seg < 2) {
#pragma unroll
            for (int ai = 0; ai < 2; ++ai) {
                u32x4 gw[4][2], hw[4][2];
#pragma unroll
                for (int m = 0; m < 4; ++m)
#pragma unroll
                    for (int bj = 0; bj < 2; ++bj) { const guc* gp = gimg + atile_off(row0 + ai * HALF + m * 16, gcol + bj * HALF, GATE_W / BK); gw[m][bj] = *(const GAS u32x4*)gp; hw[m][bj] = *(const GAS u32x4*)(gp + (size_t)(D / BK) * (2 * HTB)); }
#pragma unroll
                for (int m = 0; m < 4; ++m)
#pragma unroll
                    for (int bj = 0; bj < 2; ++bj) { f32x4 g0, g1, h0, h1; unpack(gw[m][bj], g0, g1); unpack(hw[m][bj], h0, h1);
#pragma unroll
                        for (int j = 0; j < 4; ++j) { g0[j] = fmaxf(g0[j], 1e-30f) * __builtin_amdgcn_rcpf(fmaxf(h0[j], 1e-30f)); g1[j] = fmaxf(g1[j], 1e-30f) * __builtin_amdgcn_rcpf(fmaxf(h1[j], 1e-30f)); }
                        acc[ai][bj][m][0] *= g0; acc[ai][bj][m][1] *= g1; }
            }
        } else {
#pragma unroll
            for (int ai = 0; ai < 2; ++ai) {
                u32x4 gw[4][2];
#pragma unroll
                for (int m = 0; m < 4; ++m)
#pragma unroll
                    for (int bj = 0; bj < 2; ++bj) gw[m][bj] = *(const GAS u32x4*)(gimg + atile_off(row0 + ai * HALF + m * 16, gcol + bj * HALF, GATE_W / BK));
#pragma unroll
                for (int m = 0; m < 4; ++m)
#pragma unroll
                    for (int bj = 0; bj < 2; ++bj) { f32x4 g0, g1; unpack(gw[m][bj], g0, g1);
#pragma unroll
                        for (int j = 0; j < 4; ++j) { g0[j] = fmaxf(g0[j], 1e-30f); g1[j] = fmaxf(g1[j], 1e-30f); }
                        *(GAS u32x4*)((guc*)merged + atile_off(row0 + ai * HALF + m * 16, col0 + bj * HALF, D / BK)) = pack8(acc[ai][bj][m][0] * g0, acc[ai][bj][m][1] * g1); }
            }
        }
    }
};
struct EpiStore {
    __device__ __forceinline__ bool keep(const Unit&) const { return false; }
    gbf* O; int ldc;
    __device__ __forceinline__ void operator()(const f32x4 (&acc)[2][2][4][2], const Unit& u, int wr, int wc, int fr, int fq) const {
        const int row0 = u.pm * BM + wr * 64 + fr, col0 = u.pn * BM + wc * 32 + 8 * fq;
#pragma unroll
        for (int ai = 0; ai < 2; ++ai)
#pragma unroll
            for (int m = 0; m < 4; ++m) {
#pragma unroll
                for (int bj = 0; bj < 2; ++bj) *(GAS u32x4*)((guc*)O + atile_off(row0 + ai * HALF + m * 16, col0 + bj * HALF, ldc / BK)) = pack8(acc[ai][bj][m][0], acc[ai][bj][m][1]); }
    }
};
struct EpiSwiglu {
    __device__ __forceinline__ bool keep(const Unit&) const { return false; }
    gbf* hid;
    __device__ __forceinline__ void operator()(const f32x4 (&acc)[2][2][4][2], const Unit& u, int wr, int wc, int fr, int fq) const {
        const int row0 = u.pm * BM + wr * 64 + fr, col0 = u.pn * HALF + wc * 32 + 8 * fq;
#pragma unroll
        for (int ai = 0; ai < 2; ++ai)
#pragma unroll
            for (int m = 0; m < 4; ++m) { f32x4 v0, v1;
#pragma unroll
                for (int j = 0; j < 4; ++j) { const float a0 = acc[ai][0][m][0][j], a1 = acc[ai][0][m][1][j];
                    v0[j] = a0 * fast_sigmoid(a0) * acc[ai][1][m][0][j]; v1[j] = a1 * fast_sigmoid(a1) * acc[ai][1][m][1][j]; }
                *(GAS u32x4*)((guc*)hid + atile_off(row0 + ai * HALF + m * 16, col0, FF / BK)) = pack8(v0, v1); }
    }
};
}

constexpr int AT_PITCH = 288, AT_TILE = 64 * AT_PITCH, AT_BUF = 2 * AT_TILE;
template <int NS>
__device__ __forceinline__ void attn_unit(LAS unsigned char* lds, const gbf* __restrict__ proj, gbf* __restrict__ mix, int b, int h, int qb,
                                          float slope2, float sink2, float lam, const gfl* __restrict__ subg, float outscale) {
    const int tid = fresh_tid(), wave = __builtin_amdgcn_readfirstlane(tid >> 6), lane = tid & 63, g = lane >> 4, i16 = lane & 15;
    const int qcol = (NS == 1 ? OFF_QA : OFF_QC) + h * 128;
    const int kcol = (NS == 1 ? OFF_KA + (h / 3) * 128 : OFF_KC + h * 128);
    const int vcol = (NS == 1 ? OFF_VA + (h / 3) * 128 : OFF_VC + h * 128);
    const int tq = qb * 128 + wave * 16 + i16;
    const gbf* rowbase = proj + (size_t)b * T * IN_W;
    bf16x8 qf[4];
#pragma unroll
    for (int kk = 0; kk < 4; ++kk) qf[kk] = *(const GAS bf16x8*)(rowbase + (size_t)tq * IN_W + qcol + kk * 32 + 8 * g);
    int jlo, jhi, kbase;
    if (NS == 1) { kbase = qb * 128 - 128; jlo = (qb == 0) ? 2 : 0; jhi = (qb == T / 128 - 1) ? 4 : 6; } else { kbase = 0; jlo = 0; jhi = T / 64; }
    const float c1 = (NS == 1 ? 0.08838834764831845f : 0.125f) * LOG2E;
    f32x4 O[NS][8]; float mrun[NS], lrun[NS];
#pragma unroll
    for (int s = 0; s < NS; ++s) { mrun[s] = (NS == 1) ? sink2 : -1e30f; lrun[s] = (NS == 1 && g == 0) ? 1.0f : 0.0f;
#pragma unroll
        for (int dt = 0; dt < 8; ++dt) O[s][dt] = (f32x4){0.f, 0.f, 0.f, 0.f}; }
    const int skey = tid >> 4, sch = tid & 15;
    u32x4 kreg[2], vreg[2];
    auto gload = [&](int j) { const int kp0 = kbase + 64 * j;
#pragma unroll
        for (int i = 0; i < 2; ++i) { const gbf* rp = rowbase + (size_t)(kp0 + skey + 32 * i) * IN_W + sch * 8;
            kreg[i] = *(const GAS u32x4*)(rp + kcol); vreg[i] = *(const GAS u32x4*)(rp + vcol); } };
    auto lstore = [&](int buf) { LAS unsigned char* bp = lds + buf * AT_BUF + (skey) * AT_PITCH + sch * 16;
#pragma unroll
        for (int i = 0; i < 2; ++i) { *(LAS u32x4*)(bp + i * 32 * AT_PITCH) = kreg[i]; *(LAS u32x4*)(bp + AT_TILE + i * 32 * AT_PITCH) = vreg[i]; } };
    gload(jlo);
    __syncthreads();
    lstore(0);
    __syncthreads();
    const int koff = i16 * AT_PITCH + 16 * g;
    const int voff = AT_TILE + (4 * g + (i16 >> 2)) * AT_PITCH + (i16 & 3) * 8;
    float slo[4][4];
#pragma unroll
    for (int kt = 0; kt < 4; ++kt)
#pragma unroll
        for (int r = 0; r < 4; ++r) slo[kt][r] = slope2 * (float)(kt * 16 + 4 * g + r);
    const int tqw = qb * 128 + wave * 16;
    constexpr float THR = 8.0f;
    for (int j = jlo; j < jhi; ++j) {
        const int buf = (j - jlo) & 1;
        if (j + 1 < jhi) gload(j + 1);
        LAS unsigned char* bp = lds + buf * AT_BUF;
        const int kp0 = kbase + 64 * j;
        f32x4 st[NS][4];
#pragma unroll
        for (int s = 0; s < NS; ++s)
#pragma unroll
            for (int kt = 0; kt < 4; ++kt) { st[s][kt] = (f32x4){0.f, 0.f, 0.f, 0.f};
#pragma unroll
                for (int kk = 0; kk < 4 / NS; ++kk) { const int kq = s * (4 / NS) + kk;
                    const bf16x8 kf = *(const LAS bf16x8*)(bp + koff + kt * 16 * AT_PITCH + kq * 64);
                    st[s][kt] = __builtin_amdgcn_mfma_f32_16x16x32_bf16(kf, qf[kq], st[s][kt], 0, 0, 0); } }
        f32x4 B[4];
        const float d0 = (float)(tq - kp0);
        if (kp0 + 63 <= tqw) {
            const float c0 = -slope2 * d0;
#pragma unroll
            for (int kt = 0; kt < 4; ++kt)
#pragma unroll
                for (int r = 0; r < 4; ++r) B[kt][r] = c0 + slo[kt][r];
        } else if (kp0 >= tqw + 15) {
            const float c0 = slope2 * d0;
#pragma unroll
            for (int kt = 0; kt < 4; ++kt)
#pragma unroll
                for (int r = 0; r < 4; ++r) B[kt][r] = c0 - slo[kt][r];
        } else {
#pragma unroll
            for (int kt = 0; kt < 4; ++kt)
#pragma unroll
                for (int r = 0; r < 4; ++r) { const float ad = fabsf(d0 - (float)(kt * 16 + 4 * g + r)); float bb = -slope2 * ad; if (NS == 1) bb = (ad <= 128.0f) ? bb : -1e30f; B[kt][r] = bb; }
        }
        if (NS == 1 && (kp0 + 63 <= tqw || kp0 >= tqw + 15)) {
#pragma unroll
            for (int kt = 0; kt < 4; ++kt)
#pragma unroll
                for (int r = 0; r < 4; ++r) { const float ad = fabsf(d0 - (float)(kt * 16 + 4 * g + r)); B[kt][r] = (ad <= 128.0f) ? B[kt][r] : -1e30f; }
        }
        bf16x8 pf[NS][2];
#pragma unroll
        for (int s = 0; s < NS; ++s) {
            float tmax = -1e30f;
#pragma unroll
            for (int kt = 0; kt < 4; ++kt) {
#pragma unroll
                for (int r = 0; r < 4; ++r) st[s][kt][r] = fmaf(st[s][kt][r], c1, B[kt][r]);
                tmax = fmaxf(tmax, fmaxf(fmaxf(st[s][kt][0], st[s][kt][1]), fmaxf(st[s][kt][2], st[s][kt][3]))); }
            if (__any(tmax > mrun[s] + THR)) {
                tmax = fmaxf(tmax, __shfl_xor(tmax, 16)); tmax = fmaxf(tmax, __shfl_xor(tmax, 32));
                const float mnew = fmaxf(mrun[s], tmax), alpha = __builtin_amdgcn_exp2f(mrun[s] - mnew); mrun[s] = mnew;
                lrun[s] *= alpha;
#pragma unroll
                for (int dt = 0; dt < 8; ++dt) O[s][dt] *= alpha;
            }
            const float mcur = mrun[s];
            float psum = 0.f;
#pragma unroll
            for (int kt = 0; kt < 4; ++kt)
#pragma unroll
                for (int r = 0; r < 4; ++r) { const float p = __builtin_amdgcn_exp2f(st[s][kt][r] - mcur); st[s][kt][r] = p; psum += p; }
            lrun[s] += psum;
#pragma unroll
            for (int k2 = 0; k2 < 2; ++k2) { u32x4 w; w.x = cvt_pk_bf16(st[s][2 * k2][0], st[s][2 * k2][1]); w.y = cvt_pk_bf16(st[s][2 * k2][2], st[s][2 * k2][3]);
                w.z = cvt_pk_bf16(st[s][2 * k2 + 1][0], st[s][2 * k2 + 1][1]); w.w = cvt_pk_bf16(st[s][2 * k2 + 1][2], st[s][2 * k2 + 1][3]); pf[s][k2] = __builtin_bit_cast(bf16x8, w); }
        }
#pragma unroll
        for (int dt = 0; dt < 8; ++dt)
#pragma unroll
            for (int k2 = 0; k2 < 2; ++k2) {
                const s16x4 lo = __builtin_bit_cast(s16x4, __builtin_amdgcn_ds_read_tr16_b64_v4i16((LAS s16x4*)(bp + voff + (k2 * 32) * AT_PITCH + dt * 32)));
                const s16x4 hi = __builtin_bit_cast(s16x4, __builtin_amdgcn_ds_read_tr16_b64_v4i16((LAS s16x4*)(bp + voff + (k2 * 32 + 16) * AT_PITCH + dt * 32)));
                const bf16x8 vf = {lo[0], lo[1], lo[2], lo[3], hi[0], hi[1], hi[2], hi[3]};
#pragma unroll
                for (int s = 0; s < NS; ++s) O[s][dt] = __builtin_amdgcn_mfma_f32_16x16x32_bf16(vf, pf[s][k2], O[s][dt], 0, 0, 0);
            }
        if (j + 1 < jhi) lstore(buf ^ 1);
        __syncthreads();
    }
    float inv[NS];
#pragma unroll
    for (int s = 0; s < NS; ++s) { float l = lrun[s]; l += __shfl_xor(l, 16); l += __shfl_xor(l, 32); inv[s] = 1.0f / l; }
    const int orow_r = b * T + tq, ocol = (NS == 1 ? 0 : MIX_C) + h * 128 + 4 * g;
    if (NS == 1) {
#pragma unroll
        for (int dt = 0; dt < 8; ++dt) { const f32x4 o = O[0][dt] * inv[0]; u32x2 w; w.x = cvt_pk_bf16(o[0], o[1]); w.y = cvt_pk_bf16(o[2], o[3]); *(GAS u32x2*)((guc*)mix + pg8::atile_off(orow_r, ocol + 16 * dt, D / 64)) = w; }
    } else {
        float ss = 0.f;
#pragma unroll
        for (int dt = 0; dt < 8; ++dt) { O[0][dt] = O[0][dt] * inv[0] - (O[NS - 1][dt] * inv[NS - 1]) * lam; const f32x4 o = O[0][dt]; ss += (o[0] * o[0] + o[1] * o[1]) + (o[2] * o[2] + o[3] * o[3]); }
        ss += __shfl_xor(ss, 16); ss += __shfl_xor(ss, 32);
        const float rs = rsqrtf(ss * (1.0f / 128.0f) + SUBLN_EPS) * outscale;
#pragma unroll
        for (int dt = 0; dt < 8; ++dt) { const f32x4 gv = *(const GAS f32x4*)(subg + 16 * dt + 4 * g); const f32x4 o = O[0][dt] * rs * gv;
            u32x2 w; w.x = cvt_pk_bf16(o[0], o[1]); w.y = cvt_pk_bf16(o[2], o[3]); *(GAS u32x2*)((guc*)mix + pg8::atile_off(orow_r, ocol + 16 * dt, D / 64)) = w; }
    }
}


constexpr int NTC = T / 64;
__device__ __forceinline__ void attn_c_fast(LAS unsigned char* lds, const gbf* __restrict__ proj, gbf* __restrict__ mix, int b, int h, int qb,
                                            float slope2, float lam, const gfl* __restrict__ subg, float outscale, float kmax2_0, float kmax2_1) {
    const int tid = fresh_tid(), wave = __builtin_amdgcn_readfirstlane(tid >> 6), lane = tid & 63, g = lane >> 4, i16 = lane & 15;
    const int qcol = OFF_QC + h * 128, kcol = OFF_KC + h * 128, vcol = OFF_VC + h * 128;
    const int tq = qb * 128 + wave * 16 + i16, tqw = qb * 128 + wave * 16;
    const gbf* rowbase = proj + (size_t)b * T * IN_W;
    const float c1 = 0.125f * LOG2E;
    bf16x8 qf[4];
#pragma unroll
    for (int kk = 0; kk < 4; ++kk) qf[kk] = *(const GAS bf16x8*)(rowbase + (size_t)tq * IN_W + qcol + kk * 32 + 8 * g);
    float mref[2];
#pragma unroll
    for (int s = 0; s < 2; ++s) { float ss = 0.f;
#pragma unroll
        for (int kk = 0; kk < 2; ++kk)
#pragma unroll
            for (int e = 0; e < 8; ++e) { const float v = __uint_as_float(((unsigned)(unsigned short)qf[2 * s + kk][e]) << 16); ss += v * v; }
        ss += __shfl_xor(ss, 16); ss += __shfl_xor(ss, 32);
        mref[s] = c1 * sqrtf(ss * (s == 0 ? kmax2_0 : kmax2_1)) + 1.0f; }
    float slo[4][4];
#pragma unroll
    for (int kt = 0; kt < 4; ++kt)
#pragma unroll
        for (int r = 0; r < 4; ++r) slo[kt][r] = (float)(kt * 16 + 4 * g + r);
    f32x4 O[2][8]; float lrun[2] = {0.f, 0.f};
#pragma unroll
    for (int s = 0; s < 2; ++s)
#pragma unroll
        for (int dt = 0; dt < 8; ++dt) O[s][dt] = (f32x4){0.f, 0.f, 0.f, 0.f};
    const int skey = tid >> 4, sch = tid & 15;
    u32x4 kreg[2], vreg[2];
    const gbf* sbase = rowbase + (size_t)skey * IN_W + sch * 8;
    LAS unsigned char* sdst = lds + skey * AT_PITCH + sch * 16;
#define C_GLOADK(j) do { _Pragma("unroll") for (int i_ = 0; i_ < 2; ++i_) kreg[i_] = *(const GAS u32x4*)(sbase + (size_t)(64 * (j) + 32 * i_) * IN_W + kcol); } while (0)
#define C_GLOADV(j) do { _Pragma("unroll") for (int i_ = 0; i_ < 2; ++i_) vreg[i_] = *(const GAS u32x4*)(sbase + (size_t)(64 * (j) + 32 * i_) * IN_W + vcol); } while (0)
#define C_LSTK(bi) do { _Pragma("unroll") for (int i_ = 0; i_ < 2; ++i_) *(LAS u32x4*)(sdst + (bi) * AT_TILE + i_ * 32 * AT_PITCH) = kreg[i_]; } while (0)
#define C_LSTV(bi) do { _Pragma("unroll") for (int i_ = 0; i_ < 2; ++i_) *(LAS u32x4*)(sdst + (2 + (bi)) * AT_TILE + i_ * 32 * AT_PITCH) = vreg[i_]; } while (0)
    const int koff = i16 * AT_PITCH + 16 * g;
    const int voff = 2 * AT_TILE + (4 * g + (i16 >> 2)) * AT_PITCH + (i16 & 3) * 8;
    u32x4 k1reg[2];
    C_GLOADK(0); C_GLOADV(0);
#pragma unroll
    for (int i_ = 0; i_ < 2; ++i_) k1reg[i_] = *(const GAS u32x4*)(sbase + (size_t)(64 + 32 * i_) * IN_W + kcol);
#define C_S(kb, stx) do { \
        _Pragma("unroll") for (int s_ = 0; s_ < 2; ++s_) _Pragma("unroll") for (int kt_ = 0; kt_ < 4; ++kt_) { stx[s_][kt_] = (f32x4){0.f, 0.f, 0.f, 0.f}; \
            _Pragma("unroll") for (int kk_ = 0; kk_ < 2; ++kk_) { const bf16x8 kf_ = *(const LAS bf16x8*)(lds + (kb) * AT_TILE + koff + kt_ * 16 * AT_PITCH + (2 * s_ + kk_) * 64); \
                stx[s_][kt_] = __builtin_amdgcn_mfma_f32_16x16x32_bf16(kf_, qf[2 * s_ + kk_], stx[s_][kt_], 0, 0, 0); } } \
    } while (0)
#define C_EXP(t, stx, pfo) do { \
        const float d0_ = (float)(tq - 64 * (t)); f32x4 B_[4]; \
        _Pragma("unroll") for (int kt_ = 0; kt_ < 4; ++kt_) _Pragma("unroll") for (int r_ = 0; r_ < 4; ++r_) B_[kt_][r_] = fabsf(d0_ - slo[kt_][r_]);     \
        _Pragma("unroll") for (int s_ = 0; s_ < 2; ++s_) { float ps_ = 0.f; const float nm_ = -mref[s_]; \
            _Pragma("unroll") for (int kt_ = 0; kt_ < 4; ++kt_) _Pragma("unroll") for (int r_ = 0; r_ < 4; ++r_) { const float p_ = __builtin_amdgcn_exp2f(fmaf(stx[s_][kt_][r_], c1, fmaf(-slope2, B_[kt_][r_], nm_))); stx[s_][kt_][r_] = p_; ps_ += p_; } \
            lrun[s_] += ps_; \
            _Pragma("unroll") for (int k2_ = 0; k2_ < 2; ++k2_) { u32x4 w_; w_.x = cvt_pk_bf16(stx[s_][2 * k2_][0], stx[s_][2 * k2_][1]); w_.y = cvt_pk_bf16(stx[s_][2 * k2_][2], stx[s_][2 * k2_][3]); \
                w_.z = cvt_pk_bf16(stx[s_][2 * k2_ + 1][0], stx[s_][2 * k2_ + 1][1]); w_.w = cvt_pk_bf16(stx[s_][2 * k2_ + 1][2], stx[s_][2 * k2_ + 1][3]); pfo[s_][k2_] = __builtin_bit_cast(bf16x8, w_); } } \
    } while (0)
#define C_PV(vb, pfi) do { \
        _Pragma("unroll") for (int dt_ = 0; dt_ < 8; ++dt_) _Pragma("unroll") for (int k2_ = 0; k2_ < 2; ++k2_) { \
            const s16x4 lo_ = __builtin_bit_cast(s16x4, __builtin_amdgcn_ds_read_tr16_b64_v4i16((LAS s16x4*)(lds + (vb) * AT_TILE + voff + (k2_ * 32) * AT_PITCH + dt_ * 32))); \
            const s16x4 hi_ = __builtin_bit_cast(s16x4, __builtin_amdgcn_ds_read_tr16_b64_v4i16((LAS s16x4*)(lds + (vb) * AT_TILE + voff + (k2_ * 32 + 16) * AT_PITCH + dt_ * 32))); \
            const bf16x8 vf_ = {lo_[0], lo_[1], lo_[2], lo_[3], hi_[0], hi_[1], hi_[2], hi_[3]}; \
            _Pragma("unroll") for (int s_ = 0; s_ < 2; ++s_) O[s_][dt_] = __builtin_amdgcn_mfma_f32_16x16x32_bf16(vf_, pfi[s_][k2_], O[s_][dt_], 0, 0, 0); } \
    } while (0)
    __syncthreads();
    C_LSTK(0); C_LSTV(0);
#pragma unroll
    for (int i_ = 0; i_ < 2; ++i_) *(LAS u32x4*)(sdst + 1 * AT_TILE + i_ * 32 * AT_PITCH) = k1reg[i_];
    __syncthreads();
    bf16x8 pf[2][2], pfn[2][2];
    { f32x4 st0[2][4]; C_S(0, st0); C_EXP(0, st0, pf); }
    __syncthreads();
#pragma nounroll
    for (int j = 0; j < NTC - 1; ++j) {
        const int jk = (j + 2 < NTC) ? j + 2 : NTC - 1;
        C_GLOADK(jk); C_GLOADV(j + 1);
        const LAS unsigned char* kbp = lds + ((j + 1) & 1) * AT_TILE + koff;
        const LAS unsigned char* vbp = lds + (j & 1) * AT_TILE + voff;
        f32x4 stn[2][4]; bf16x8 kfr[3][4], vfr[3][2];
#define C_LDK(kt, bi) do { _Pragma("unroll") for (int q_ = 0; q_ < 4; ++q_) kfr[bi][q_] = *(const LAS bf16x8*)(kbp + (kt) * 16 * AT_PITCH + q_ * 64); } while (0)
#define C_LDV(dt, bi) do { _Pragma("unroll") for (int k2_ = 0; k2_ < 2; ++k2_) { \
            const s16x4 lo_ = __builtin_bit_cast(s16x4, __builtin_amdgcn_ds_read_tr16_b64_v4i16((LAS s16x4*)(vbp + (k2_ * 32) * AT_PITCH + (dt) * 32))); \
            const s16x4 hi_ = __builtin_bit_cast(s16x4, __builtin_amdgcn_ds_read_tr16_b64_v4i16((LAS s16x4*)(vbp + (k2_ * 32 + 16) * AT_PITCH + (dt) * 32))); \
            vfr[bi][k2_] = (bf16x8){lo_[0], lo_[1], lo_[2], lo_[3], hi_[0], hi_[1], hi_[2], hi_[3]}; } } while (0)
        C_LDK(0, 0); C_LDK(1, 1);
#pragma unroll
        for (int kt = 0; kt < 4; ++kt) {
            __builtin_amdgcn_sched_barrier(0);
            if (kt < 2) C_LDK(kt + 2, (kt + 2) % 3); else C_LDV(kt - 2, kt - 2);
#pragma unroll
            for (int s_ = 0; s_ < 2; ++s_) { stn[s_][kt] = (f32x4){0.f, 0.f, 0.f, 0.f};
#pragma unroll
                for (int kk = 0; kk < 2; ++kk) stn[s_][kt] = __builtin_amdgcn_mfma_f32_16x16x32_bf16(kfr[kt % 3][2 * s_ + kk], qf[2 * s_ + kk], stn[s_][kt], 0, 0, 0); }
        }
        const float dq = (float)(tq - 64 * (j + 1) - 4 * g);
        float ps0 = 0.f, ps1 = 0.f; const float nm0 = -mref[0], nm1 = -mref[1];
#pragma unroll
        for (int dt = 0; dt < 8; ++dt) {
            __builtin_amdgcn_sched_barrier(0);
            if (dt < 6) C_LDV(dt + 2, (dt + 2) % 3);
#pragma unroll
            for (int k2 = 0; k2 < 2; ++k2)
#pragma unroll
                for (int s_ = 0; s_ < 2; ++s_) O[s_][dt] = __builtin_amdgcn_mfma_f32_16x16x32_bf16(vfr[dt % 3][k2], pf[s_][k2], O[s_][dt], 0, 0, 0);
#pragma unroll
            for (int rr = 0; rr < 2; ++rr) { const int kt = dt >> 1, r = 2 * (dt & 1) + rr; const float bb = -slope2 * fabsf(dq - (float)(kt * 16 + r));
                const float p0 = __builtin_amdgcn_exp2f(fmaf(stn[0][kt][r], c1, bb + nm0)), p1 = __builtin_amdgcn_exp2f(fmaf(stn[1][kt][r], c1, bb + nm1));
                stn[0][kt][r] = p0; stn[1][kt][r] = p1; ps0 += p0; ps1 += p1; }
        }
        __builtin_amdgcn_sched_barrier(0);
#undef C_LDK
#undef C_LDV
        lrun[0] += ps0; lrun[1] += ps1;
#pragma unroll
        for (int s_ = 0; s_ < 2; ++s_)
#pragma unroll
            for (int k2 = 0; k2 < 2; ++k2) { u32x4 w_; w_.x = cvt_pk_bf16(stn[s_][2 * k2][0], stn[s_][2 * k2][1]); w_.y = cvt_pk_bf16(stn[s_][2 * k2][2], stn[s_][2 * k2][3]);
                w_.z = cvt_pk_bf16(stn[s_][2 * k2 + 1][0], stn[s_][2 * k2 + 1][1]); w_.w = cvt_pk_bf16(stn[s_][2 * k2 + 1][2], stn[s_][2 * k2 + 1][3]); pfn[s_][k2] = __builtin_bit_cast(bf16x8, w_); }
        C_LSTK(j & 1); C_LSTV((j + 1) & 1);
        __syncthreads();
#pragma unroll
        for (int s = 0; s < 2; ++s)
#pragma unroll
            for (int k2 = 0; k2 < 2; ++k2) pf[s][k2] = pfn[s][k2];
    }
    C_PV((NTC - 1) & 1, pf);
#undef C_GLOADK
#undef C_GLOADV
#undef C_LSTK
#undef C_LSTV
#undef C_S
#undef C_EXP
#undef C_PV
    float inv[2];
#pragma unroll
    for (int s = 0; s < 2; ++s) { float l = lrun[s]; l += __shfl_xor(l, 16); l += __shfl_xor(l, 32); inv[s] = 1.0f / l; }
    const int orow_r = b * T + tq, ocol = MIX_C + h * 128 + 4 * g;
    float ss = 0.f;
#pragma unroll
    for (int dt = 0; dt < 8; ++dt) { O[0][dt] = O[0][dt] * inv[0] - (O[1][dt] * inv[1]) * lam; const f32x4 o = O[0][dt]; ss += (o[0] * o[0] + o[1] * o[1]) + (o[2] * o[2] + o[3] * o[3]); }
    ss += __shfl_xor(ss, 16); ss += __shfl_xor(ss, 32);
    const float rs = rsqrtf(ss * (1.0f / 128.0f) + SUBLN_EPS) * outscale;
#pragma unroll
    for (int dt = 0; dt < 8; ++dt) { const f32x4 gv = *(const GAS f32x4*)(subg + 16 * dt + 4 * g); const f32x4 o = O[0][dt] * rs * gv;
        u32x2 w; w.x = cvt_pk_bf16(o[0], o[1]); w.y = cvt_pk_bf16(o[2], o[3]); *(GAS u32x2*)((guc*)mix + pg8::atile_off(orow_r, ocol + 16 * dt, D / 64)) = w; }
}

__device__ __forceinline__ void transpose_item(const gfl* __restrict__ W, int N, int k0, int n0, guc* __restrict__ dimg, int r0, int nkt, LAS float* scr, int lane) {
#pragma unroll 8
    for (int i = 0; i < 32; ++i) { const int kk = 2 * i + (lane >> 5); scr[kk * 33 + (lane & 31)] = W[(size_t)(k0 + kk) * N + n0 + (lane & 31)]; }
    LDS_WAIT(); asm volatile("" ::: "memory");
    const int c = lane & 7;
#pragma unroll
    for (int j = 0; j < 4; ++j) { const int n = (lane >> 3) + 8 * j; const LAS float* s = scr + (8 * c) * 33 + n;
        u32x4 o; o.x = cvt_pk_bf16(s[0 * 33], s[1 * 33]); o.y = cvt_pk_bf16(s[2 * 33], s[3 * 33]); o.z = cvt_pk_bf16(s[4 * 33], s[5 * 33]); o.w = cvt_pk_bf16(s[6 * 33], s[7 * 33]);
        *(GAS u32x4*)(dimg + pg8::btile_off(r0 + n, k0 >> 6, c, nkt)) = o; }
    LDS_WAIT(); asm volatile("" ::: "memory");
}

__device__ __forceinline__ void acc8(float (&s)[8], u32x4 w, float sg) {
    asm volatile("" : "+v"(w));
    s[0] += sg * bf_lo(w.x); s[1] += sg * bf_hi(w.x); s[2] += sg * bf_lo(w.y); s[3] += sg * bf_hi(w.y); s[4] += sg * bf_lo(w.z); s[5] += sg * bf_hi(w.z); s[6] += sg * bf_lo(w.w); s[7] += sg * bf_hi(w.w);
}
template <int R>
__device__ __forceinline__ void stencil_block(const gbf* __restrict__ up, int t0, guc* __restrict__ zimg, int m0, int ch) {
    guc* zlo = zimg + pg8::atile_off(m0, ch * 8, POOLW / 64); guc* zhi = zimg + pg8::atile_off(m0 + 8, ch * 8, POOLW / 64);
    u32x4 wv[16 + 2 * R];
#pragma unroll
    for (int k = 0; k < 16 + 2 * R; ++k) { const int q = t0 - R + k; const bool ok = (q >= 0) && (q < T); wv[k] = *(const GAS u32x4*)(up + (size_t)(ok ? q : t0) * IN_W); }
    __builtin_amdgcn_sched_barrier(0);
#pragma unroll
    for (int k = 0; k < 16 + 2 * R; ++k) { const int q = t0 - R + k; const bool ok = (q >= 0) && (q < T); if (!ok) wv[k] = (u32x4){0u, 0u, 0u, 0u}; }
    float s[8];
#pragma unroll
    for (int j = 0; j < 8; ++j) s[j] = 0.f;
#pragma unroll
    for (int k = 0; k < 2 * R + 1; ++k) acc8(s, wv[k], 1.0f);
#pragma unroll
    for (int i = 0; i < 16; ++i) {
        const int t = t0 + i, tlo = (t - R < 0) ? 0 : t - R, thi = (t + R + 1 > T) ? T : t + R + 1; const float ic = __builtin_amdgcn_rcpf((float)(thi - tlo));
        u32x4 w = wv[R + i]; asm volatile("" : "+v"(w));
        u32x4 o; o.x = cvt_pk_bf16(s[0] * ic - bf_lo(w.x), s[1] * ic - bf_hi(w.x)); o.y = cvt_pk_bf16(s[2] * ic - bf_lo(w.y), s[3] * ic - bf_hi(w.y));
        o.z = cvt_pk_bf16(s[4] * ic - bf_lo(w.z), s[5] * ic - bf_hi(w.z)); o.w = cvt_pk_bf16(s[6] * ic - bf_lo(w.w), s[7] * ic - bf_hi(w.w));
        *(GAS u32x4*)((i < 8 ? zlo : zhi) + (i & 7) * 64) = o;
        if (i < 15) { acc8(s, wv[i + 2 * R + 1], 1.0f); acc8(s, wv[i], -1.0f); }
    }
}

struct Args { const float* in[21]; float* out; unsigned char* ws; int ph_lo, ph_hi; };
enum { I_X = 0, I_C, I_ADAW, I_ADAB, I_MPRE, I_MPOST, I_WIN, I_SINK, I_POOLW, I_PSCALE, I_LAMBDA, I_SUBG, I_WGATE, I_BGATE, I_WBRANCH, I_WOUT, I_FPRE, I_FPOST, I_FWG, I_FWU, I_FWD };

template <bool SRC_BF, bool DST_BF>
__device__ __forceinline__ void rownorm_phase(const void GAS* xsrc_, void GAS* xdst_, const gbf* y, const gfl* gpost, const gfl* gate,
                                              const gfl* gpre, const gfl* shift, const gfl* scale, gbf* hdst, int bx, int G, LAS unsigned char* lds) {
    const int tid = fresh_tid(), lane = tid & 63, wave = __builtin_amdgcn_readfirstlane(tid >> 6);
    const bool al = (G & 7) == 0;
    const int b0 = al ? (bx & 7) : 0, bstep = al ? 8 : 1, cb = al ? (bx >> 3) : bx, nb = al ? (G >> 3) : G;
    LAS float* pa = (LAS float*)lds; LAS float* pb = pa + D; LAS float* pc = pb + D;
    for (int b = b0; b < BATCH; b += bstep) {
        __syncthreads();
        { const int c0 = tid * 8;
#pragma unroll
          for (int q = 0; q < 2; ++q) { const int c = c0 + 4 * q;
            if (y) { const f32x4 g = *(const GAS f32x4*)(gate + (size_t)b * ADA + c), p = *(const GAS f32x4*)(gpost + c); *(LAS f32x4*)(pa + c) = g * p; }
            if (hdst) { const f32x4 p = *(const GAS f32x4*)(gpre + c), sc = *(const GAS f32x4*)(scale + (size_t)b * ADA + c), sh = *(const GAS f32x4*)(shift + (size_t)b * ADA + c);
                *(LAS f32x4*)(pb + c) = p * (1.0f + sc); *(LAS f32x4*)(pc + c) = sh; } } }
        __syncthreads();
        constexpr int NR = SRC_BF ? 2 : 1;
        constexpr int QS = 8;
        for (int r = cb * 8 * NR + wave; r < T; r += NR * nb * 8) {
            u32x2 xw[NR][16], yw[NR][16]; f32x4 xf[SRC_BF ? 1 : 16];
#pragma unroll
            for (int q = 0; q < NR; ++q) { const int rq = (r + q * QS < T) ? r + q * QS : r; const int m = b * T + rq; const size_t ro = (size_t)m * D + 4 * lane;
                if constexpr (SRC_BF) {
#pragma unroll
                    for (int j = 0; j < 16; ++j) xw[q][j] = *(const GAS u32x2*)((const gbf*)xsrc_ + ro + 256 * j);
                } else {
#pragma unroll
                    for (int j = 0; j < 16; ++j) xf[j] = *(const GAS f32x4*)((const gfl*)xsrc_ + ro + 256 * j);
                }
                if (y) {
#pragma unroll
                    for (int j = 0; j < 16; ++j) yw[q][j] = *(const GAS u32x2*)((const guc*)y + pg8::atile_off(m, 4 * lane + 256 * j, D / 64));
                } }
#pragma unroll
            for (int q = 0; q < NR; ++q) {
                if (r + q * QS >= T) break;
                const int m = b * T + r + q * QS; const size_t ro = (size_t)m * D + 4 * lane;
                f32x4 xv[16];
#pragma unroll
                for (int j = 0; j < 16; ++j) { if constexpr (SRC_BF) xv[j] = (f32x4){bf_lo(xw[q][j].x), bf_hi(xw[q][j].x), bf_lo(xw[q][j].y), bf_hi(xw[q][j].y)}; else xv[j] = xf[j]; }
                if (y) {
                    float ss = 0.f;
#pragma unroll
                    for (int j = 0; j < 16; ++j) { const f32x4 yv = {bf_lo(yw[q][j].x), bf_hi(yw[q][j].x), bf_lo(yw[q][j].y), bf_hi(yw[q][j].y)}; ss += (yv[0] * yv[0] + yv[1] * yv[1]) + (yv[2] * yv[2] + yv[3] * yv[3]); }
                    const float rstd = rsqrtf(wave_sum(ss) * (1.0f / D) + NORM_EPS);
#pragma unroll
                    for (int j = 0; j < 16; ++j) { const f32x4 av = *(const LAS f32x4*)(pa + 4 * lane + 256 * j);
                        const f32x4 yv = {bf_lo(yw[q][j].x), bf_hi(yw[q][j].x), bf_lo(yw[q][j].y), bf_hi(yw[q][j].y)};
                        xv[j] += av * (yv * rstd);
                        if constexpr (DST_BF) { u32x2 w; w.x = cvt_pk_bf16(xv[j][0], xv[j][1]); w.y = cvt_pk_bf16(xv[j][2], xv[j][3]); *(GAS u32x2*)((gbf*)xdst_ + ro + 256 * j) = w;
                            xv[j] = (f32x4){bf_lo(w.x), bf_hi(w.x), bf_lo(w.y), bf_hi(w.y)}; }
                        else *(GAS f32x4*)((gfl*)xdst_ + ro + 256 * j) = xv[j];
                        if ((j & 3) == 3) asm volatile("" ::: "memory"); }
                }
                if (hdst) {
                    float ss = 0.f;
#pragma unroll
                    for (int j = 0; j < 16; ++j) ss += (xv[j][0] * xv[j][0] + xv[j][1] * xv[j][1]) + (xv[j][2] * xv[j][2] + xv[j][3] * xv[j][3]);
                    const float rstd = rsqrtf(wave_sum(ss) * (1.0f / D) + NORM_EPS);
#pragma unroll
                    for (int j = 0; j < 16; ++j) { const f32x4 bv = *(const LAS f32x4*)(pb + 4 * lane + 256 * j), cv = *(const LAS f32x4*)(pc + 4 * lane + 256 * j);
                        const f32x4 hv = (xv[j] * rstd) * bv + cv; u32x2 w; w.x = cvt_pk_bf16(hv[0], hv[1]); w.y = cvt_pk_bf16(hv[2], hv[3]); *(GAS u32x2*)((guc*)hdst + pg8::atile_off(m, 4 * lane + 256 * j, D / 64)) = w;
                        if ((j & 3) == 3) asm volatile("" ::: "memory"); }
                }
            }
        }
    }
    __syncthreads();
}

__global__ void __launch_bounds__(512, 2) fwd(Args a) {
    extern __shared__ __attribute__((aligned(16))) unsigned char lds_raw[];
    LAS unsigned char* lds = (LAS unsigned char*)lds_raw;
    unsigned* ctl = (unsigned*)(a.ws + WS_CTL);
    volatile LAS unsigned* MISC = (volatile LAS unsigned*)(lds + MISC_OFF);
    for (int u = threadIdx.x; u < (LDS_BYTES - LDSCTL_OFF) / 4; u += 512) ((LAS unsigned*)(lds + LDSCTL_OFF))[u] = 0u;
    __syncthreads();
    const int lo = a.ph_lo, hi = a.ph_hi;
    XcdBarrier bar; bar.bar = ctl + CW_BAR; bar.x = 0; bar.st = nullptr;
    if (hi - lo > 1) bar = xcd_barrier_post(ctl + CW_BAR, MISC + 8);
#define IN(k) (lo <= (k) && (k) < hi)
#define SEAM(k) do { if (IN(k) && IN((k) + 1)) xcd_barrier(bar); } while (0)
#define INP(k) ((const gfl*)a.in[opq(k)])
#define WSB ((guc*)opqp(a.ws))
#define MODP ((gfl*)(WSB + WS_MOD))
#define HB ((gbf*)(WSB + WS_H))
#define MIXP ((gbf*)(WSB + WS_MIX))
#define MERGP ((gbf*)(WSB + WS_MERG))
#define YB ((gbf*)(WSB + WS_Y))
#define XBP ((gbf*)(WSB + WS_M32))
#define ZB ((gbf*)(WSB + WS_Z))
#define PROJP ((gbf*)(WSB + WS_PROJ))
#define GATESP ((gbf*)(WSB + WS_GATES))
#define HIDP ((gbf*)(WSB + WS_HID))
#define WLAYER(l) (WSB + WS_W + (size_t)(l) * W_LAYER)
#define GEOM() const int G = opq((int)gridDim.x), bx = opq((int)blockIdx.x), vcu = (G % 8 == 0) ? (bx % 8) * (G / 8) + bx / 8 : bx; (void)vcu

    if (IN(0)) {
        GEOM();
        {
            LAS float* cond = (LAS float*)lds;
            const int tid = fresh_tid();
            const int cq = tid % 24, kg = tid / 24;
            const gfl* cin = INP(I_C); const gfl* adaw = INP(I_ADAW); const gfl* adab = INP(I_ADAB); gfl* mod = MODP;
            for (int slab = vcu; slab < DEPTH * ADA / 96; slab += G) {
                const int l = slab / (ADA / 96), col0 = (slab % (ADA / 96)) * 96;
                for (int i = tid; i < BATCH * D; i += 512) { const int b = i / D, k = i % D; const float v = cin[i]; cond[k * 8 + b] = v / (1.0f + __expf(-v)); }
                __syncthreads();
                float acc[8][4];
#pragma unroll
                for (int b = 0; b < 8; ++b)
#pragma unroll
                    for (int j = 0; j < 4; ++j) acc[b][j] = 0.f;
                if (kg < 21) {
                    const gfl* wp = adaw + (size_t)l * D * ADA + col0 + cq * 4;
#pragma unroll 1
                    for (int k0 = kg; k0 < D; k0 += 21 * 12) {
                        f32x4 wb[12];
#pragma unroll
                        for (int q = 0; q < 12; ++q) { const int kq = k0 + 21 * q; wb[q] = *(const GAS f32x4*)(wp + (size_t)(kq < D ? kq : kg) * ADA); }
                        __builtin_amdgcn_sched_barrier(0);
#pragma unroll
                        for (int q = 0; q < 12; ++q) { const int kq = k0 + 21 * q; const int k = (kq < D) ? kq : kg; const float wm = (kq < D) ? 1.0f : 0.0f;
                        const f32x4 w = wb[q] * wm;
                        const f32x4 c0 = *(const LAS f32x4*)(cond + k * 8), c1 = *(const LAS f32x4*)(cond + k * 8 + 4);
#pragma unroll
                        for (int j = 0; j < 4; ++j) { acc[0][j] += c0[0] * w[j]; acc[1][j] += c0[1] * w[j]; acc[2][j] += c0[2] * w[j]; acc[3][j] += c0[3] * w[j];
                            acc[4][j] += c1[0] * w[j]; acc[5][j] += c1[1] * w[j]; acc[6][j] += c1[2] * w[j]; acc[7][j] += c1[3] * w[j]; }
                        }
                    }
                }
                __syncthreads();
                LAS float* part = (LAS float*)lds;
                if (kg < 21) {
#pragma unroll
                    for (int b = 0; b < 8; ++b) *(LAS f32x4*)(part + (kg * 8 + b) * 96 + cq * 4) = (f32x4){acc[b][0], acc[b][1], acc[b][2], acc[b][3]};
                }
                __syncthreads();
                for (int o = tid; o < 8 * 96; o += 512) { const int b = o / 96, cc = o % 96; float s = adab[(size_t)l * ADA + col0 + cc];
                    for (int q = 0; q < 21; ++q) s += part[(q * 8 + b) * 96 + cc];
                    mod[((size_t)l * BATCH + b) * ADA + col0 + cc] = s; }
                __syncthreads();
            }
        }
        {
            const int tid = fresh_tid(), lane = tid & 63, wave = __builtin_amdgcn_readfirstlane(tid >> 6), gw = vcu * 8 + wave, ngw = G * 8;
            LAS float* scr = (LAS float*)(lds + wave * 8448);
            constexpr int I_IN = 64 * (IN_W / 32), I_GT = 64 * (GATE_W / 32), I_BR = 64 * (D / 32), I_OUT = I_BR, I_FG = 64 * (FF / 32), I_FU = I_FG, I_FD = (FF / 64) * (D / 32), I_PW = 4 * 4 * 8;
            constexpr int PER_LAYER = I_IN + I_GT + I_BR + I_OUT + I_FG + I_FU + I_FD + I_PW;
            for (int it = gw; it < DEPTH * PER_LAYER; it += ngw) {
                const int l = it / PER_LAYER; int r = it - l * PER_LAYER;
                guc* wl = WLAYER(l);
                if (r < I_IN) { const int nb = r % (IN_W / 32), kb = r / (IN_W / 32);
                    transpose_item(INP(I_WIN) + (size_t)l * D * IN_W, IN_W, kb * 64, nb * 32, wl + W_1, nb * 32, D / 64, scr, lane); continue; } r -= I_IN;
                if (r < I_GT) { const int nb = r % (GATE_W / 32), kb = r / (GATE_W / 32);
                    transpose_item(INP(I_WGATE) + (size_t)l * D * GATE_W, GATE_W, kb * 64, nb * 32, wl + W_1, IN_W + nb * 32, D / 64, scr, lane); continue; } r -= I_GT;
                if (r < I_BR) { const int nb = r % (D / 32), kb = r / (D / 32);
                    transpose_item(INP(I_WBRANCH) + (size_t)l * D * D, D, kb * 64, nb * 32, wl + W_B, nb * 32, D / 64, scr, lane); continue; } r -= I_BR;
                if (r < I_OUT) { const int nb = r % (D / 32), kb = r / (D / 32);
                    transpose_item(INP(I_WOUT) + (size_t)l * D * D, D, kb * 64, nb * 32, wl + W_O, nb * 32, D / 64, scr, lane); continue; } r -= I_OUT;
                if (r < I_FG) { const int nb = r % (FF / 32), kb = r / (FF / 32); const int n0 = nb * 32, row = (n0 / 128) * 256 + (n0 % 128);
                    transpose_item(INP(I_FWG) + (size_t)l * D * FF, FF, kb * 64, n0, wl + W_F, row, D / 64, scr, lane); continue; } r -= I_FG;
                if (r < I_FU) { const int nb = r % (FF / 32), kb = r / (FF / 32); const int n0 = nb * 32, row = (n0 / 128) * 256 + 128 + (n0 % 128);
                    transpose_item(INP(I_FWU) + (size_t)l * D * FF, FF, kb * 64, n0, wl + W_F, row, D / 64, scr, lane); continue; } r -= I_FU;
                if (r < I_FD) { const int nb = r % (D / 32), kb = r / (D / 32);
                    transpose_item(INP(I_FWD) + (size_t)l * FF * D, D, kb * 64, nb * 32, wl + W_D, nb * 32, FF / 64, scr, lane); continue; } r -= I_FD;
                { const int gi = r / 32, rr = r % 32, nb = rr % 8, kb = rr / 8;
                    transpose_item(INP(I_POOLW) + ((size_t)l * 4 + gi) * 256 * 256, 256, kb * 64, nb * 32, WSB + WS_PWT + (size_t)l * 1024 * 256 * 2, gi * 256 + nb * 32, 4, scr, lane); }
            }
        }
    }
    SEAM(0);
    if (IN(1)) { GEOM(); const gfl* mod = MODP; rownorm_phase<false, true>(INP(I_X), (void GAS*)nullptr, (const gbf*)nullptr, (const gfl*)nullptr, (const gfl*)nullptr, INP(I_MPRE), mod + 0 * D, mod + 1 * D, HB, bx, G, lds); }
    SEAM(1);

#pragma nounroll
    for (int l = 0; l < DEPTH; ++l) {
        const int pb = 2 + 9 * l;
        if (IN(pb + 0)) {
            GEOM();
            typedef pg8::Prob<1, 0, 0, D / 64, 0, 0> PT; PT P{HB, (const gbf*)(WLAYER(l) + W_1), D / 64, D / 64, M / 256, N1 / 256, G, bx, 0, 0};
            pg8::EpiInGate E{PROJP, GATESP, INP(I_BGATE) + (size_t)l * GATE_W, (GAS unsigned*)(WSB + WS_CTL) + CW_NMAX + l * 1024};
            pg8::gemm_phase<pg8::EpiInGate, PT, true, true>(lds, P, E);
        }
        SEAM(pb + 0);
        const bool zlocal = (opq((int)gridDim.x) == (M / 256) * 4);
        if (IN(pb + 1) && !zlocal) {
            GEOM();
            const int tid = fresh_tid(); const gbf* proj = PROJP; gbf* zb = ZB;
            for (int it = (vcu * 512 + tid); it < M * 128; it += G * 512) {
                const int m = it >> 7, ch = it & 127, t = m % T, r = 1 << (ch >> 5);
                const int tlo = (t - r < 0) ? 0 : t - r, thi = (t + r + 1 > T) ? T : t + r + 1;
                const gbf* up = proj + (size_t)(m - t) * IN_W + OFF_U + ch * 8;
                float s[8];
#pragma unroll
                for (int j = 0; j < 8; ++j) s[j] = 0.f;
                u32x4 wv[17];
#pragma unroll
                for (int k = 0; k < 17; ++k) { const int q = t - 8 + k; const bool ok = (q >= tlo) && (q < thi); wv[k] = ok ? *(const GAS u32x4*)(up + (size_t)(ok ? q : t) * IN_W) : (u32x4){0u, 0u, 0u, 0u}; }
#pragma unroll
                for (int k = 0; k < 17; ++k) { const u32x4 w = wv[k];
                    s[0] += bf_lo(w.x); s[1] += bf_hi(w.x); s[2] += bf_lo(w.y); s[3] += bf_hi(w.y); s[4] += bf_lo(w.z); s[5] += bf_hi(w.z); s[6] += bf_lo(w.w); s[7] += bf_hi(w.w); }
                const u32x4 w = *(const GAS u32x4*)(up + (size_t)t * IN_W); const float ic = 1.0f / (float)(thi - tlo);
                u32x4 o; o.x = cvt_pk_bf16(s[0] * ic - bf_lo(w.x), s[1] * ic - bf_hi(w.x)); o.y = cvt_pk_bf16(s[2] * ic - bf_lo(w.y), s[3] * ic - bf_hi(w.y));
                o.z = cvt_pk_bf16(s[4] * ic - bf_lo(w.z), s[5] * ic - bf_hi(w.z)); o.w = cvt_pk_bf16(s[6] * ic - bf_lo(w.w), s[7] * ic - bf_hi(w.w));
                *(GAS u32x4*)((guc*)zb + pg8::atile_off(m, ch * 8, POOLW / 64)) = o;
            }
        }
        if (!zlocal) SEAM(pb + 1);
        if (IN(pb + 2)) {
            const float lam_init = (l == 0) ? 0.2f : (0.8f - 0.6f * 0.7408182206817179f);
            {
                GEOM();
                typedef pg8::Prob<1, 0, 0, 4, 0, 0> PT; PT P{ZB, (const gbf*)(WSB + WS_PWT) + (size_t)l * 1024 * 256, POOLW / 64, 4, M / 256, 4, G, bx, 256, 0};
                if (zlocal) {
                    pg8::Unit u0;
                    if (P.next(0, u0)) { const int tid = fresh_tid(), m0 = u0.pm * 256 + (tid >> 5) * 16, t0 = m0 % T, ch = u0.pn * 32 + (tid & 31);
                        const gbf* up = PROJP + (size_t)(m0 - t0) * IN_W + OFF_U + ch * 8; guc* zimg = (guc*)ZB;
                        if (u0.pn == 0) stencil_block<1>(up, t0, zimg, m0, ch); else if (u0.pn == 1) stencil_block<2>(up, t0, zimg, m0, ch);
                        else if (u0.pn == 2) stencil_block<4>(up, t0, zimg, m0, ch); else stencil_block<8>(up, t0, zimg, m0, ch); }
                    __syncthreads();
                }
                pg8::EpiPool E{MIXP, INP(I_PSCALE) + (size_t)l * POOLW};
                pg8::gemm_phase<pg8::EpiPool, PT, false, true>(lds, P, E);
            }
            {
                GEOM(); const gbf* proj = PROJP; gbf* mix = MIXP; const gfl* sinkp = INP(I_SINK) + l * 12;
                for (int u = vcu; u < BATCH * 12 * 16; u += G) {
                    const int qb = u & 15, hh = (u >> 4) % 12, b = u / (16 * 12);
                    const float slope2 = exp2f(-8.0f * (float)(hh + 1) / 12.0f) * LOG2E, sink2 = sinkp[hh] * LOG2E;
                    attn_unit<1>(lds, proj, mix, b, hh, qb, slope2, sink2, 0.f, (const gfl*)nullptr, 1.f);
                }
            }
            {
                GEOM(); const gbf* proj = PROJP; gbf* mix = MIXP; const gfl* subg = INP(I_SUBG) + (size_t)l * 128;
                const gfl* lv = INP(I_LAMBDA) + (size_t)l * 256; const int lane = fresh_tid() & 63;
                const float s1 = wave_sum(lv[lane] * lv[64 + lane]), s2 = wave_sum(lv[128 + lane] * lv[192 + lane]);
                const float lam = __expf(s1) - __expf(s2) + lam_init;
                for (int u = vcu; u < BATCH * 12 * 16; u += G) {
                    const int qb = u & 15, hh = (u >> 4) % 12, b = u / (16 * 12);
                    const float slope2 = exp2f(-8.0f * (float)(hh + 1) / 12.0f) * LOG2E;
                    const GAS unsigned* nm = (const GAS unsigned*)(WSB + WS_CTL) + CW_NMAX + l * 1024 + b * 48 + hh * 4;
                    const float q0 = 1.01f * (__uint_as_float(nm[0]) + __uint_as_float(nm[1])), q1 = 1.01f * (__uint_as_float(nm[2]) + __uint_as_float(nm[3]));
                    const float k0 = 1.01f * (__uint_as_float(nm[BATCH * 48]) + __uint_as_float(nm[BATCH * 48 + 1])), k1 = 1.01f * (__uint_as_float(nm[BATCH * 48 + 2]) + __uint_as_float(nm[BATCH * 48 + 3]));
                    const float bound = 0.125f * LOG2E * sqrtf(fmaxf(q0 * k0, q1 * k1));
                    if (bound <= 60.0f) attn_c_fast(lds, proj, mix, b, hh, qb, slope2, lam, subg, 1.0f - lam_init, k0, k1);
                    else attn_unit<2>(lds, proj, mix, b, hh, qb, slope2, 0.f, lam, subg, 1.0f - lam_init);
                }
            }
        }
        SEAM(pb + 2);
        if (IN(pb + 3)) {
            GEOM();
            typedef pg8::Prob<3, MIX_B, MIX_C, 1536 / 64, 1024 / 64, 1536 / 64> PT; PT P{MIXP, (const gbf*)(WLAYER(l) + W_B), D / 64, D / 64, M / 256, D / 256, G, bx, 0, 1};
            pg8::EpiBranch E{GATESP, MERGP};
            pg8::gemm_phase<pg8::EpiBranch, PT, true, true>(lds, P, E);
        }
        SEAM(pb + 3);
        if (IN(pb + 4)) {
            GEOM();
            typedef pg8::Prob<1, 0, 0, D / 64, 0, 0> PT; PT P{MERGP, (const gbf*)(WLAYER(l) + W_O), D / 64, D / 64, M / 256, D / 256, G, bx, 0, 0};
            pg8::EpiStore E{YB, D};
            pg8::gemm_phase<pg8::EpiStore, PT, true, true>(lds, P, E);
        }
        SEAM(pb + 4);
        if (IN(pb + 5)) { GEOM(); const gfl* modl = MODP + (size_t)l * BATCH * ADA;
            if (l == 0) rownorm_phase<false, true>(INP(I_X), XBP, YB, INP(I_MPOST) + (size_t)l * D, modl + 2 * D, INP(I_FPRE) + (size_t)l * D, modl + 3 * D, modl + 4 * D, HB, bx, G, lds);
            else rownorm_phase<true, true>(XBP, XBP, YB, INP(I_MPOST) + (size_t)l * D, modl + 2 * D, INP(I_FPRE) + (size_t)l * D, modl + 3 * D, modl + 4 * D, HB, bx, G, lds); }
        SEAM(pb + 5);
        if (IN(pb + 6)) {
            GEOM();
            typedef pg8::Prob<1, 0, 0, D / 64, 0, 0> PT; PT P{HB, (const gbf*)(WLAYER(l) + W_F), D / 64, D / 64, M / 256, NF / 256, G, bx, 0, 0};
            pg8::EpiSwiglu E{HIDP};
            pg8::gemm_phase<pg8::EpiSwiglu, PT, true, true>(lds, P, E);
        }
        SEAM(pb + 6);
        if (IN(pb + 7)) {
            GEOM();
            typedef pg8::Prob<1, 0, 0, FF / 64, 0, 0> PT; PT P{HIDP, (const gbf*)(WLAYER(l) + W_D), FF / 64, FF / 64, M / 256, D / 256, G, bx, 0, 0};
            pg8::EpiStore E{YB, D};
            pg8::gemm_phase<pg8::EpiStore, PT, true, true>(lds, P, E);
        }
        SEAM(pb + 7);
        if (IN(pb + 8)) {
            GEOM(); const gfl* modl = MODP + (size_t)l * BATCH * ADA;
            const bool more = (l + 1 < DEPTH); const int ln = more ? l + 1 : l; const gfl* modn = MODP + (size_t)ln * BATCH * ADA;
            if (more) rownorm_phase<true, true>(XBP, XBP, YB, INP(I_FPOST) + (size_t)l * D, modl + 5 * D, INP(I_MPRE) + (size_t)ln * D, modn + 0 * D, modn + 1 * D, HB, bx, G, lds);
            else rownorm_phase<true, false>(XBP, (gfl*)a.out, YB, INP(I_FPOST) + (size_t)l * D, modl + 5 * D, INP(I_MPRE) + (size_t)ln * D, modn + 0 * D, modn + 1 * D, (gbf*)nullptr, bx, G, lds);
        }
        SEAM(pb + 8);
    }
#undef IN
#undef SEAM
}


constexpr int N_PHASES = 2 + 9 * DEPTH;
extern "C" void kernel_launch(void* const* d_in, const int* in_sizes, int n_in, void* d_out, int out_size, void* d_ws, size_t ws_size, hipStream_t stream) {
    static int grid = 0;
    if (grid == 0) {
        if (n_in != 21 || in_sizes[0] != M * D || out_size != M * D || ws_size < WS_END) { fprintf(stderr, "kernel_launch: unexpected shapes (n_in %d, in0 %d, out %d, ws %zu < %zu)\n", n_in, n_in > 0 ? in_sizes[0] : -1, out_size, ws_size, (size_t)WS_END); grid = -1; return; }
        int dev = 0, cus = 0, per_cu = 0;
        if (hipGetDevice(&dev) != hipSuccess || hipDeviceGetAttribute(&cus, hipDeviceAttributeMultiprocessorCount, dev) != hipSuccess) { grid = -1; return; }
        if (hipFuncSetAttribute((const void*)fwd, hipFuncAttributeMaxDynamicSharedMemorySize, LDS_BYTES) != hipSuccess) { fprintf(stderr, "kernel_launch: hipFuncSetAttribute failed\n"); grid = -1; return; }
        if (hipOccupancyMaxActiveBlocksPerMultiprocessor(&per_cu, (const void*)fwd, 512, LDS_BYTES) != hipSuccess || per_cu < 1) fprintf(stderr, "kernel_launch: occupancy query reports %d\n", per_cu);
        (void)hipGetLastError();
        grid = cus;
    }
    if (grid < 0) return;
    if (hipMemsetAsync((char*)d_ws + WS_CTL, 0, CTL_ZERO_BYTES, stream) != hipSuccess) return;
    Args a{};
    for (int i = 0; i < 21; ++i) a.in[i] = (const float*)d_in[i];
    a.out = (float*)d_out; a.ws = (unsigned char*)d_ws;
#if MK_N_LAUNCHES == 1
    a.ph_lo = 0; a.ph_hi = N_PHASES;
    hipLaunchKernelGGL(fwd, dim3(grid), dim3(512), LDS_BYTES, stream, a);
#else
    for (int p = 0; p < N_PHASES; ++p) { a.ph_lo = p; a.ph_hi = p + 1; hipLaunchKernelGGL(fwd, dim3(grid), dim3(512), LDS_BYTES, stream, a); }
#endif
}
```

```cpp
#include <hip/hip_runtime.h>
#include <cstdio>
#include <cstdint>

#ifndef MK_N_LAUNCHES
#define MK_N_LAUNCHES 1
#endif

#define LAS __attribute__((address_space(3)))
#define GAS __attribute__((address_space(1)))
typedef unsigned short bf16_t;
typedef short bf16x8 __attribute__((ext_vector_type(8)));
typedef short s16x4 __attribute__((ext_vector_type(4)));
typedef float f32x4 __attribute__((ext_vector_type(4)));
typedef float f32x2 __attribute__((ext_vector_type(2)));
typedef unsigned u32x4 __attribute__((ext_vector_type(4)));
typedef unsigned u32x2 __attribute__((ext_vector_type(2)));
typedef GAS bf16_t gbf;
typedef GAS float gfl;
typedef GAS unsigned char guc;

constexpr int D = 4096, BATCH = 8, T = 2048, DEPTH = 2, M = BATCH * T;
constexpr int IN_W = 8192, GATE_W = 12288, N1 = IN_W + GATE_W;
constexpr int FF = 11008, NF = 2 * FF;
constexpr int ADA = 6 * D;
constexpr int OFF_QA = 0, OFF_KA = 1536, OFF_VA = 2048, OFF_U = 2560, OFF_QC = 3584, OFF_KC = 5120, OFF_VC = 6656;
constexpr int MIX_B = 1536, MIX_C = 2560;
constexpr int POOLW = 1024;
constexpr float NORM_EPS = 1e-6f, SUBLN_EPS = 1e-5f;
constexpr float LOG2E = 1.4426950408889634f;

constexpr size_t MiB = 1u << 20;
constexpr size_t WS_CTL = 0, CTL_ZERO_BYTES = 1 * MiB;
constexpr size_t WS_MOD = 1 * MiB;
constexpr size_t WS_PWT = 3 * MiB;
constexpr size_t WS_W = 4 * MiB, W_LAYER = 482 * MiB;
constexpr size_t W_1 = 0, W_B = 160 * MiB, W_O = 192 * MiB, W_F = 224 * MiB, W_D = 396 * MiB;
constexpr size_t WS_H = 968 * MiB, WS_MIX = 1096 * MiB, WS_MERG = 1224 * MiB, WS_Y = 1352 * MiB, WS_M32 = 1480 * MiB, WS_Z = 1736 * MiB;
constexpr size_t WS_PROJ = 1768 * MiB, WS_GATES = 2024 * MiB, WS_HID = WS_PROJ, WS_END = 2408 * MiB;
static_assert(WS_W + 2 * W_LAYER == WS_H, "ws map");
static_assert((size_t)M * FF * 2 <= WS_END - WS_HID, "hid overlay");
constexpr int CW_TMO = 0, CW_BAR = 4096, CW_NMAX = 32768;

constexpr int RING_BYTES = 131072;
constexpr int LDSCTL_OFF = RING_BYTES, MISC_OFF = LDSCTL_OFF + 320;
constexpr int LDS_BYTES = 147456;

#define LDS_WAIT() asm volatile("s_waitcnt lgkmcnt(0)" ::: "memory")
#define VM_WAIT() asm volatile("s_waitcnt vmcnt(0)" ::: "memory")

typedef float f32x2_t __attribute__((ext_vector_type(2))); typedef __bf16 bf16x2_t __attribute__((ext_vector_type(2)));
__device__ __forceinline__ unsigned cvt_pk_bf16(float lo, float hi) { f32x2_t v = {lo, hi}; bf16x2_t b = __builtin_convertvector(v, bf16x2_t); return __builtin_bit_cast(unsigned, b); }
__device__ __forceinline__ float bf_lo(unsigned w) { return __uint_as_float(w << 16); }
__device__ __forceinline__ float bf_hi(unsigned w) { return __uint_as_float(w & 0xffff0000u); }
__device__ __forceinline__ float wave_sum(float v) {
#pragma unroll
    for (int o = 1; o < 64; o <<= 1) v += __shfl_xor(v, o);
    return v;
}
__device__ __forceinline__ int opq(int k) { asm volatile("" : "+s"(k)); return k; }
template <class TP> __device__ __forceinline__ TP* opqp(TP* p) { asm volatile("" : "+s"(p)); return p; }
__device__ __forceinline__ int fresh_tid() { int t = threadIdx.x; asm volatile("" : "+v"(t)); return t; }
__device__ __forceinline__ float fast_sigmoid(float x) { return __builtin_amdgcn_rcpf(1.0f + __builtin_amdgcn_exp2f(-x * LOG2E)); }

#define XB_TMO      128
#define XB_XCNT(j)  (256  + 64 * (j))
#define XB_XSUB(j)  (1280 + 64 * (j))
#define XB_XGEN(j)  (2304 + 64 * (j))
#define XB_TOP      3328
#define XB_TOPGEN   3392
#define XCD_BAR_WORDS 3456
#define XB_SPIN_CAP (1u << 18)
__device__ __forceinline__ unsigned xb_ld(unsigned* p)              { return __hip_atomic_load(p, __ATOMIC_RELAXED, __HIP_MEMORY_SCOPE_AGENT); }
__device__ __forceinline__ unsigned xb_add(unsigned* p, unsigned v) { return __hip_atomic_fetch_add(p, v, __ATOMIC_RELAXED, __HIP_MEMORY_SCOPE_AGENT); }
__device__ __forceinline__ unsigned xb_xcc_id() { return (unsigned)__builtin_amdgcn_s_getreg((3 << 11) | 20) & 0xFu; }
#define XB_SPIN(cond, bar) do { unsigned _sp = 0; while (cond) { __builtin_amdgcn_s_sleep(1); \
    if ((++_sp & 255u) == 0u) { if (xb_ld(&(bar)[XB_TMO])) break; if (_sp > XB_SPIN_CAP) { atomicAdd(&(bar)[XB_TMO], 1u); break; } } } } while (0)
struct XcdBarrier { unsigned* bar; unsigned x; volatile LAS unsigned* st; };
__device__ __forceinline__ XcdBarrier xcd_barrier_post(unsigned* bar, volatile LAS unsigned* st) {
    XcdBarrier b; b.bar = bar; b.x = xb_xcc_id(); b.st = st;
    if (threadIdx.x == 0) (void)xb_add(&bar[XB_XCNT(b.x)], 1u);
    return b;
}
__device__ __forceinline__ void xcd_barrier_complete(unsigned* bar, unsigned x, unsigned& nloc, unsigned& nx) {
    const unsigned G = gridDim.x * gridDim.y * gridDim.z;
    unsigned sum, cnt, mine, sp = 0u;
    for (;;) {
        sum = 0u; cnt = 0u; mine = 0u;
#pragma unroll
        for (unsigned j = 0; j < 16; ++j) { const unsigned c = xb_ld(&bar[XB_XCNT(j)]); sum += c; cnt += (c > 0u) ? 1u : 0u; mine = (j == x) ? c : mine; }
        if (sum == G) break;
        __builtin_amdgcn_s_sleep(1);
        if ((++sp & 255u) == 0u) { if (xb_ld(&bar[XB_TMO])) break; if (sp > XB_SPIN_CAP) { atomicAdd(&bar[XB_TMO], 1u); break; } }
    }
    nloc = mine > 0u ? mine : 1u; nx = cnt > 0u ? cnt : 1u;
}
__device__ __forceinline__ void xcd_barrier(const XcdBarrier& b) {
    asm volatile("s_waitcnt vmcnt(0)" ::: "memory");
    __syncthreads();
    if (threadIdx.x == 0) {
        unsigned* bar = b.bar;
        __builtin_amdgcn_s_waitcnt(0);
        unsigned nloc = b.st[0], nx = b.st[1];
        if (nloc == 0u) { xcd_barrier_complete(bar, b.x, nloc, nx); b.st[0] = nloc; b.st[1] = nx; }
        const unsigned old = xb_add(&bar[XB_XSUB(b.x)], 1u);
        const unsigned gen = old / nloc;
        if (old + 1u == (gen + 1u) * nloc) {
            __builtin_amdgcn_fence(__ATOMIC_RELEASE, "agent");
            asm volatile("s_waitcnt vmcnt(0)" ::: "memory");
            const unsigned og = xb_add(&bar[XB_TOP], 1u);
            const unsigned tg = og / nx;
            if (og + 1u == (tg + 1u) * nx) xb_add(&bar[XB_TOPGEN], 1u);
            else XB_SPIN(xb_ld(&bar[XB_TOPGEN]) == tg, bar);
            __builtin_amdgcn_fence(__ATOMIC_ACQUIRE, "agent");
            xb_add(&bar[XB_XGEN(b.x)], 1u);
            asm volatile("s_waitcnt vmcnt(0)" ::: "memory");
        } else {
            XB_SPIN(xb_ld(&bar[XB_XGEN(b.x)]) == gen, bar);
            __builtin_amdgcn_fence(__ATOMIC_ACQUIRE, "agent");
            asm volatile("s_waitcnt vmcnt(0)" ::: "memory");
        }
    }
    __syncthreads();
}

namespace pg8 {
constexpr int BM = 256, BK = 64, HALF = 128, HTB = HALF * BK * 2, STAGE_BYTES = 8 * HTB, NXCD = 8, WGM = 8;
__host__ __device__ __forceinline__ int lds_byte(int r, int c) { const int st = (r >> 4) * 2 + (c >> 5), rr = r & 15, cc = c & 31, ob = rr * 64 + cc * 2; return st * 1024 + (ob ^ (((ob >> 9) & 1) << 5)); }
__host__ __device__ __forceinline__ void stage_rc(int b, int& R, int& C) { const int st = b / 1024, sb = b % 1024, swz = sb ^ (((sb >> 9) & 1) << 5); R = (st >> 1) * 16 + swz / 64; C = (st & 1) * 32 + (swz % 64) / 2; }
__host__ __device__ __forceinline__ int perm32(int rho) { const int n = rho >> 4, i = rho & 15; return 8 * (i >> 2) + 4 * n + (i & 3); }

__host__ __device__ __forceinline__ size_t btile_off(int r, int kt, int c8, int nkt) {
    const int pn = r >> 8, half = (r >> 7) & 1, rl = r & 127, q = rl & 31, rho = (rl & ~31) + 16 * ((q >> 2) & 1) + 4 * (q >> 3) + (q & 3);
    return ((size_t)pn * nkt + kt) * (size_t)(2 * HTB) + (size_t)half * HTB + lds_byte(rho, 8 * c8);
}
__host__ __device__ __forceinline__ size_t atile_off(int r, int k, int nkt) {
    return ((size_t)(r >> 8) * nkt + (k >> 6)) * (size_t)(2 * HTB) + (size_t)((r >> 7) & 1) * HTB + lds_byte(r & 127, k & 56) + (k & 7) * 2;
}
struct Unit { int pm, pn, seg; };
template <int NSEG, int AK1, int AK2, int NT0, int NT1, int NT2>
struct Prob {
    const gbf* A; const gbf* B; int lda, ldb;
    int nM, nN, G, c, apn, bshare;
    __device__ __forceinline__ bool next(int i, Unit& u) const {
        const int nwg = nM * nN; if (c >= nwg) return false;
        const int nr = (nwg - c + G - 1) / G;
        int seg = 0, j = i;
        if constexpr (NSEG > 1) { j = i / NSEG; seg = i - j * NSEG; }
        if (j >= nr) return false;
        int wgid = j * G + c; { const int q = nwg / NXCD, r = nwg % NXCD, xcd = wgid % NXCD, off = wgid / NXCD; wgid = (xcd < r ? xcd * (q + 1) : r * (q + 1) + (xcd - r) * q) + off; }
        const int nig = WGM * nN, gid = wgid / nig, fm = gid * WGM, gsz = (nM - fm) < WGM ? (nM - fm) : WGM;
        u.pm = fm + ((wgid % nig) % gsz); u.pn = (wgid % nig) / gsz; u.seg = seg; return true;
    }
    __device__ __forceinline__ int nt(const Unit& u) const { if constexpr (NSEG == 1) return NT0; else return u.seg == 0 ? NT0 : (u.seg == 1 ? NT1 : NT2); }
    __device__ __forceinline__ int ak(const Unit& u) const { if constexpr (NSEG == 1) return 0; else return u.seg == 0 ? 0 : (u.seg == 1 ? AK1 : AK2); }
    __device__ __forceinline__ const GAS char* a_ptr(const Unit& u) const { return (const GAS char*)A + ((size_t)u.pm * lda + (ak(u) + u.pn * apn) / BK) * (size_t)(2 * HTB); }
    __device__ __forceinline__ const GAS char* b_ptr(const Unit& u) const { return (const GAS char*)B + ((size_t)u.pn * ldb + (bshare ? ak(u) / BK : 0)) * (size_t)(2 * HTB); }
};

template <class Epi, class ProbT, bool ALIGN_EPI, bool SP2>
__device__ __forceinline__ void gemm_phase(LAS unsigned char* lds, const ProbT& P, const Epi& E) {
    const int tid = fresh_tid(), wid = __builtin_amdgcn_readfirstlane(tid >> 6), lane = tid & 63, wr = wid >> 2, wc = wid & 3, fr = lane & 15, fq = lane >> 4;
    unsigned voffA[2], voffB[2];
#pragma unroll
    for (int i = 0; i < 2; ++i) { int R, C; stage_rc(tid * 16 + i * 8192, R, C); const int Rb = (R & ~31) + perm32(R & 31);
        voffA[i] = (unsigned)(tid * 16 + i * 8192); voffB[i] = voffA[i]; (void)Rb; (void)R; (void)C; }
    const size_t kstepB = (size_t)(2 * HTB), kstep = kstepB;
    const size_t hstepA = (size_t)HTB, hstepB = (size_t)HTB;
    const unsigned ldsw = (unsigned)wid * 1024u;
    const int aoff = lds_byte(wr * 64 + fr, fq * 8), boff = lds_byte(wc * 32 + fr, fq * 8);
#define PG8_SA(b, h) (((b) * 2 + (h)) * HTB)
#define PG8_SB(b, h) ((4 + (b) * 2 + (h)) * HTB)
#define PG8_STAGE(bufoff, gbase, voff) do { _Pragma("unroll") for (int _i = 0; _i < 2; ++_i) \
        __builtin_amdgcn_global_load_lds((const GAS unsigned*)((const GAS char*)(gbase) + (voff)[_i]), (LAS unsigned*)(lds + (bufoff) + ldsw + _i * 8192), 16, 0, 0); } while (0)
#define PG8_LDA(dst, b, h) do { _Pragma("unroll") for (int m = 0; m < 4; ++m) _Pragma("unroll") for (int k = 0; k < 2; ++k) dst[m][k] = *(const LAS bf16x8*)(lds + PG8_SA(b, h) + aoff + m * 2048 + k * 1024); } while (0)
#define PG8_LDB(dst, b, h) do { _Pragma("unroll") for (int n = 0; n < 2; ++n) _Pragma("unroll") for (int k = 0; k < 2; ++k) dst[n][k] = *(const LAS bf16x8*)(lds + PG8_SB(b, h) + boff + n * 2048 + k * 1024); } while (0)
#define PG8_MMA(ai, bj, At, Bt) do { __builtin_amdgcn_s_setprio(1); _Pragma("unroll") for (int m = 0; m < 4; ++m) _Pragma("unroll") for (int n = 0; n < 2; ++n) _Pragma("unroll") for (int k = 0; k < 2; ++k) \
        acc[ai][bj][m][n] = __builtin_amdgcn_mfma_f32_16x16x32_bf16(Bt[n][k], At[m][k], acc[ai][bj][m][n], 0, 0, 0); __builtin_amdgcn_s_setprio(0); } while (0)
#define PG8_WAIT_V(n) asm volatile("s_waitcnt vmcnt(" #n ")" ::: "memory")
#define PG8_WAIT_L(n) asm volatile("s_waitcnt lgkmcnt(" #n ")" ::: "memory")
#define PG8_BAR __builtin_amdgcn_s_barrier()
#define PG8_SCHED __builtin_amdgcn_sched_barrier(0)
    Unit cur, nxt; int ui = 0;
    if (!P.next(0, cur)) return;
    f32x4 acc[2][2][4][2];
#pragma unroll
    for (int a = 0; a < 2; ++a)
#pragma unroll
        for (int b = 0; b < 2; ++b)
#pragma unroll
            for (int m = 0; m < 4; ++m)
#pragma unroll
                for (int n = 0; n < 2; ++n) acc[a][b][m][n] = (f32x4){0.f, 0.f, 0.f, 0.f};
    bf16x8 At[4][2], B0[2][2], B1[2][2];
    const GAS char* cA = P.a_ptr(cur); const GAS char* cB = P.b_ptr(cur); int nt = P.nt(cur);
    if constexpr (SP2) {
        PG8_STAGE(PG8_SB(0, 0), cB, voffB); PG8_STAGE(PG8_SB(0, 1), cB + hstepB, voffB); PG8_STAGE(PG8_SA(0, 0), cA, voffA); PG8_STAGE(PG8_SA(0, 1), cA + hstepA, voffA);
        if (wr == 1) PG8_BAR;
        PG8_WAIT_V(2); PG8_BAR;
        PG8_STAGE(PG8_SB(1, 0), cB + kstepB, voffB); PG8_STAGE(PG8_SA(1, 0), cA + kstep, voffA); PG8_STAGE(PG8_SB(1, 1), cB + hstepB + kstepB, voffB);
        PG8_WAIT_V(6); PG8_BAR;
    } else {
        PG8_STAGE(PG8_SB(0, 0), cB, voffB); PG8_STAGE(PG8_SA(0, 0), cA, voffA); PG8_STAGE(PG8_SB(0, 1), cB + hstepB, voffB); PG8_STAGE(PG8_SA(0, 1), cA + hstepA, voffA);
        if (wr == 1) PG8_BAR;
        PG8_WAIT_V(4); PG8_BAR;
        PG8_STAGE(PG8_SB(1, 0), cB + kstepB, voffB); PG8_STAGE(PG8_SA(1, 0), cA + kstep, voffA); PG8_STAGE(PG8_SB(1, 1), cB + hstepB + kstepB, voffB);
        PG8_WAIT_V(6); PG8_BAR;
    }
    for (;;) {
        const bool has_next = P.next(ui + 1, nxt);
        const GAS char* nA = has_next ? P.a_ptr(nxt) : cA; const GAS char* nB = has_next ? P.b_ptr(nxt) : cB;
#pragma nounroll
        for (int t = 0; t < nt; t += 2) {
            const bool last = (t == nt - 2);
            const GAS char* a1 = cA + (size_t)(t + 1) * kstep;
            const GAS char* a2 = last ? nA : cA + (size_t)(t + 2) * kstep; const GAS char* b2 = last ? nB : cB + (size_t)(t + 2) * kstepB;
            const GAS char* a3 = a2 + kstep; const GAS char* b3 = b2 + kstepB;
            if constexpr (SP2) {
            PG8_LDB(B0, 0, 0); PG8_LDB(B1, 0, 1); PG8_SCHED; PG8_LDA(At, 0, 0); PG8_STAGE(PG8_SA(1, 1), a1 + hstepA, voffA);
            PG8_WAIT_V(8); PG8_WAIT_L(0); PG8_BAR; PG8_MMA(0, 0, At, B0); PG8_MMA(0, 1, At, B1); PG8_BAR; PG8_SCHED;
            PG8_LDA(At, 0, 1); PG8_STAGE(PG8_SB(0, 0), b2, voffB); PG8_STAGE(PG8_SB(0, 1), b2 + hstepB, voffB); PG8_STAGE(PG8_SA(0, 0), a2, voffA);
            PG8_WAIT_V(8); PG8_WAIT_L(0); PG8_BAR; PG8_MMA(1, 0, At, B0); PG8_MMA(1, 1, At, B1); PG8_BAR; PG8_SCHED;
            PG8_LDB(B0, 1, 0); PG8_LDB(B1, 1, 1); PG8_SCHED; PG8_LDA(At, 1, 0); PG8_STAGE(PG8_SA(0, 1), a2 + hstepA, voffA);
            PG8_WAIT_V(8); PG8_WAIT_L(0); PG8_BAR; PG8_MMA(0, 0, At, B0); PG8_MMA(0, 1, At, B1); PG8_BAR; PG8_SCHED;
            PG8_LDA(At, 1, 1); PG8_STAGE(PG8_SB(1, 0), b3, voffB); PG8_STAGE(PG8_SB(1, 1), b3 + hstepB, voffB); PG8_STAGE(PG8_SA(1, 0), a3, voffA);
            PG8_WAIT_V(8); PG8_WAIT_L(0); PG8_BAR; PG8_MMA(1, 0, At, B0); PG8_MMA(1, 1, At, B1); PG8_BAR; PG8_SCHED;
            } else {
            PG8_LDB(B0, 0, 0); PG8_SCHED; PG8_LDA(At, 0, 0); PG8_STAGE(PG8_SA(1, 1), a1 + hstepA, voffA);
            PG8_WAIT_L(8); PG8_BAR; PG8_WAIT_L(0); PG8_MMA(0, 0, At, B0); PG8_BAR; PG8_SCHED;
            PG8_LDB(B1, 0, 1); PG8_STAGE(PG8_SB(0, 0), b2, voffB);
            PG8_BAR; PG8_WAIT_L(0); PG8_MMA(0, 1, At, B1); PG8_BAR;
            PG8_LDA(At, 0, 1); PG8_STAGE(PG8_SA(0, 0), a2, voffA);
            PG8_BAR; PG8_WAIT_L(0); PG8_MMA(1, 0, At, B0); PG8_BAR; PG8_SCHED;
            PG8_STAGE(PG8_SB(0, 1), b2 + hstepB, voffB);
            PG8_WAIT_V(6); PG8_BAR; PG8_MMA(1, 1, At, B1); PG8_BAR;
            PG8_LDB(B0, 1, 0); PG8_SCHED; PG8_LDA(At, 1, 0); PG8_STAGE(PG8_SA(0, 1), a2 + hstepA, voffA);
            PG8_WAIT_L(8); PG8_BAR; PG8_WAIT_L(0); PG8_MMA(0, 0, At, B0); PG8_BAR; PG8_SCHED;
            PG8_LDB(B1, 1, 1); PG8_STAGE(PG8_SB(1, 0), b3, voffB);
            PG8_BAR; PG8_WAIT_L(0); PG8_MMA(0, 1, At, B1); PG8_BAR;
            PG8_LDA(At, 1, 1); PG8_STAGE(PG8_SA(1, 0), a3, voffA);
            PG8_BAR; PG8_WAIT_L(0); PG8_MMA(1, 0, At, B0); PG8_BAR; PG8_SCHED;
            PG8_STAGE(PG8_SB(1, 1), b3 + hstepB, voffB);
            PG8_WAIT_V(6); PG8_BAR; PG8_MMA(1, 1, At, B1); PG8_BAR;
            }
        }
        if constexpr (ALIGN_EPI) { if (wr == 0) PG8_BAR; }
        E(acc, cur, wr, wc, fr, fq);
        if (!has_next) break;
        if (!E.keep(cur)) {
#pragma unroll
        for (int a = 0; a < 2; ++a)
#pragma unroll
            for (int b = 0; b < 2; ++b)
#pragma unroll
                for (int m = 0; m < 4; ++m)
#pragma unroll
                    for (int n = 0; n < 2; ++n) acc[a][b][m][n] = (f32x4){0.f, 0.f, 0.f, 0.f};
        }
        cur = nxt; cA = nA; cB = nB; nt = P.nt(cur); ++ui;
        if constexpr (ALIGN_EPI) { if (wr == 1) PG8_BAR; }
    }
    PG8_WAIT_V(0);
    if constexpr (!ALIGN_EPI) { if (wr == 0) PG8_BAR; }
    PG8_BAR;
#undef PG8_SA
#undef PG8_SB
#undef PG8_STAGE
#undef PG8_LDA
#undef PG8_LDB
#undef PG8_MMA
#undef PG8_WAIT_V
#undef PG8_WAIT_L
#undef PG8_BAR
#undef PG8_SCHED
}

__device__ __forceinline__ u32x4 pack8(const f32x4 v0, const f32x4 v1) { u32x4 w; w.x = cvt_pk_bf16(v0[0], v0[1]); w.y = cvt_pk_bf16(v0[2], v0[3]); w.z = cvt_pk_bf16(v1[0], v1[1]); w.w = cvt_pk_bf16(v1[2], v1[3]); return w; }

struct EpiInGate {
    __device__ __forceinline__ bool keep(const Unit&) const { return false; }
    gbf* proj; gbf* gates; const gfl* bgate; GAS unsigned* nmax;
    __device__ __forceinline__ void operator()(const f32x4 (&acc)[2][2][4][2], const Unit& u, int wr, int wc, int fr, int fq) const {
        const int row0 = u.pm * BM + wr * 64 + fr;
        if (u.pn < IN_W / BM) {
            const int col0 = u.pn * BM + wc * 32 + 8 * fq;
            if (u.pn >= OFF_QC / BM && u.pn < OFF_VC / BM) {
#pragma unroll
                for (int bj = 0; bj < 2; ++bj) {
                    float mx = 0.f;
#pragma unroll
                    for (int ai = 0; ai < 2; ++ai)
#pragma unroll
                        for (int m = 0; m < 4; ++m) { const f32x4 a = acc[ai][bj][m][0], e = acc[ai][bj][m][1];
                            float ss = (a[0] * a[0] + a[1] * a[1]) + (a[2] * a[2] + a[3] * a[3]) + (e[0] * e[0] + e[1] * e[1]) + (e[2] * e[2] + e[3] * e[3]);
                            ss += __shfl_xor(ss, 16); ss += __shfl_xor(ss, 32); mx = fmaxf(mx, ss); }
                    mx = fmaxf(mx, __shfl_xor(mx, 1)); mx = fmaxf(mx, __shfl_xor(mx, 2)); mx = fmaxf(mx, __shfl_xor(mx, 4)); mx = fmaxf(mx, __shfl_xor(mx, 8));
                    const int cq = u.pn * BM + bj * HALF + wc * 32 - OFF_QC;
                    const int qk = cq >= (OFF_KC - OFF_QC) ? 1 : 0, g32 = (cq - qk * (OFF_KC - OFF_QC)) >> 5, bb = (u.pm * BM) / T;
                    if (fr == 0 && fq == 0) __hip_atomic_fetch_max(nmax + (qk * BATCH + bb) * 48 + g32, __float_as_uint(mx), __ATOMIC_RELAXED, __HIP_MEMORY_SCOPE_AGENT);
                }
            }
#pragma unroll
            for (int ai = 0; ai < 2; ++ai)
#pragma unroll
                for (int m = 0; m < 4; ++m) { gbf* rowp = proj + (size_t)(row0 + ai * HALF + m * 16) * IN_W + col0;
#pragma unroll
                    for (int bj = 0; bj < 2; ++bj) *(GAS u32x4*)(rowp + bj * HALF) = pack8(acc[ai][bj][m][0], acc[ai][bj][m][1]); }
        } else {
            const int col0 = (u.pn - IN_W / BM) * BM + wc * 32 + 8 * fq;
            f32x4 bv[2][2];
#pragma unroll
            for (int bj = 0; bj < 2; ++bj)
#pragma unroll
                for (int n = 0; n < 2; ++n) bv[bj][n] = *(const GAS f32x4*)(bgate + col0 + bj * HALF + 4 * n);
#pragma unroll
            for (int ai = 0; ai < 2; ++ai)
#pragma unroll
                for (int m = 0; m < 4; ++m) {
#pragma unroll
                    for (int bj = 0; bj < 2; ++bj) { f32x4 v0 = acc[ai][bj][m][0] + bv[bj][0], v1 = acc[ai][bj][m][1] + bv[bj][1];
#pragma unroll
                        for (int j = 0; j < 4; ++j) { v0[j] = fast_sigmoid(v0[j]); v1[j] = fast_sigmoid(v1[j]); }
                        *(GAS u32x4*)((guc*)gates + atile_off(row0 + ai * HALF + m * 16, col0 + bj * HALF, GATE_W / BK)) = pack8(v0, v1); } }
        }
    }
};
struct EpiPool {
    __device__ __forceinline__ bool keep(const Unit&) const { return false; }
    gbf* mix; const gfl* pscale;
    __device__ __forceinline__ void operator()(const f32x4 (&acc)[2][2][4][2], const Unit& u, int wr, int wc, int fr, int fq) const {
        const int row0 = u.pm * BM + wr * 64 + fr, col0 = u.pn * BM + wc * 32 + 8 * fq;
        f32x4 sv[2][2];
#pragma unroll
        for (int bj = 0; bj < 2; ++bj)
#pragma unroll
            for (int n = 0; n < 2; ++n) sv[bj][n] = *(const GAS f32x4*)(pscale + col0 + bj * HALF + 4 * n);
#pragma unroll
        for (int ai = 0; ai < 2; ++ai)
#pragma unroll
            for (int m = 0; m < 4; ++m) {
#pragma unroll
                for (int bj = 0; bj < 2; ++bj) *(GAS u32x4*)((guc*)mix + atile_off(row0 + ai * HALF + m * 16, MIX_B + col0 + bj * HALF, D / BK)) = pack8(acc[ai][bj][m][0] * sv[bj][0], acc[ai][bj][m][1] * sv[bj][1]); }
    }
};
struct EpiBranch {
    const gbf* gates; gbf* merged;
    __device__ __forceinline__ bool keep(const Unit& u) const { return u.seg < 2; }
    __device__ __forceinline__ static void unpack(const u32x4 w, f32x4& lo, f32x4& hi) { lo = (f32x4){bf_lo(w.x), bf_hi(w.x), bf_lo(w.y), bf_hi(w.y)}; hi = (f32x4){bf_lo(w.z), bf_hi(w.z), bf_lo(w.w), bf_hi(w.w)}; }
    __device__ __forceinline__ void operator()(f32x4 (&acc)[2][2][4][2], const Unit& u, int wr, int wc, int fr, int fq) const {
        const int row0 = u.pm * BM + wr * 64 + fr, col0 = u.pn * BM + wc * 32 + 8 * fq;
        const guc* gimg = (const guc*)gates; const int gcol = u.seg * D + col0;
        if (u.seg < 2) {
#pragma unroll
            for (int ai = 0; ai < 2; ++ai) {
                u32x4 gw[4][2], hw[4][2];
#pragma unroll
                for (int m = 0; m < 4; ++m)
#pragma unroll
                    for (int bj = 0; bj < 2; ++bj) { const guc* gp = gimg + atile_off(row0 + ai * HALF + m * 16, gcol + bj * HALF, GATE_W / BK); gw[m][bj] = *(const GAS u32x4*)gp; hw[m][bj] = *(const GAS u32x4*)(gp + (size_t)(D / BK) * (2 * HTB)); }
#pragma unroll
                for (int m = 0; m < 4; ++m)
#pragma unroll
                    for (int bj = 0; bj < 2; ++bj) { f32x4 g0, g1, h0, h1; unpack(gw[m][bj], g0, g1); unpack(hw[m][bj], h0, h1);
#pragma unroll
                        for (int j = 0; j < 4; ++j) { g0[j] = fmaxf(g0[j], 1e-30f) * __builtin_amdgcn_rcpf(fmaxf(h0[j], 1e-30f)); g1[j] = fmaxf(g1[j], 1e-30f) * __builtin_amdgcn_rcpf(fmaxf(h1[j], 1e-30f)); }
                        acc[ai][bj][m][0] *= g0; acc[ai][bj][m][1] *= g1; }
            }
        } else {
#pragma unroll
            for (int ai = 0; ai < 2; ++ai) {
                u32x4 gw[4][2];
#pragma unroll
                for (int m = 0; m < 4; ++m)
#pragma unroll
                    for (int bj = 0; bj < 2; ++bj) gw[m][bj] = *(const GAS u32x4*)(gimg + atile_off(row0 + ai * HALF + m * 16, gcol + bj * HALF, GATE_W / BK));
#pragma unroll
                for (int m = 0; m < 4; ++m)
#pragma unroll
                    for (int bj = 0; bj < 2; ++bj) { f32x4 g0, g1; unpack(gw[m][bj], g0, g1);
#pragma unroll
                        for (int j = 0; j < 4; ++j) { g0[j] = fmaxf(g0[j], 1e-30f); g1[j] = fmaxf(g1[j], 1e-30f); }
                        *(GAS u32x4*)((guc*)merged + atile_off(row0 + ai * HALF + m * 16, col0 + bj * HALF, D / BK)) = pack8(acc[ai][bj][m][0] * g0, acc[ai][bj][m][1] * g1); }
            }
        }
    }
};
struct EpiStore {
    __device__ __forceinline__ bool keep(const Unit&) const { return false; }
    gbf* O; int ldc;
    __device__ __forceinline__ void operator()(const f32x4 (&acc)[2][2][4][2], const Unit& u, int wr, int wc, int fr, int fq) const {
        const int row0 = u.pm * BM + wr * 64 + fr, col0 = u.pn * BM + wc * 32 + 8 * fq;
#pragma unroll
        for (int ai = 0; ai < 2; ++ai)
#pragma unroll
            for (int m = 0; m < 4; ++m) {
#pragma unroll
                for (int bj = 0; bj < 2; ++bj) *(GAS u32x4*)((guc*)O + atile_off(row0 + ai * HALF + m * 16, col0 + bj * HALF, ldc / BK)) = pack8(acc[ai][bj][m][0], acc[ai][bj][m][1]); }
    }
};
struct EpiSwiglu {
    __device__ __forceinline__ bool keep(const Unit&) const { return false; }
    gbf* hid;
    __device__ __forceinline__ void operator()(const f32x4 (&acc)[2][2][4][2], const Unit& u, int wr, int wc, int fr, int fq) const {
        const int row0 = u.pm * BM + wr * 64 + fr, col0 = u.pn * HALF + wc * 32 + 8 * fq;
#pragma unroll
        for (int ai = 0; ai < 2; ++ai)
#pragma unroll
            for (int m = 0; m < 4; ++m) { f32x4 v0, v1;
#pragma unroll
                for (int j = 0; j < 4; ++j) { const float a0 = acc[ai][0][m][0][j], a1 = acc[ai][0][m][1][j];
                    v0[j] = a0 * fast_sigmoid(a0) * acc[ai][1][m][0][j]; v1[j] = a1 * fast_sigmoid(a1) * acc[ai][1][m][1][j]; }
                *(GAS u32x4*)((guc*)hid + atile_off(row0 + ai * HALF + m * 16, col0, FF / BK)) = pack8(v0, v1); }
    }
};
}

constexpr int AT_PITCH = 288, AT_TILE = 64 * AT_PITCH, AT_BUF = 2 * AT_TILE;
template <int NS>
__device__ __forceinline__ void attn_unit(LAS unsigned char* lds, const gbf* __restrict__ proj, gbf* __restrict__ mix, int b, int h, int qb,
                                          float slope2, float sink2, float lam, const gfl* __restrict__ subg, float outscale) {
    const int tid = fresh_tid(), wave = __builtin_amdgcn_readfirstlane(tid >> 6), lane = tid & 63, g = lane >> 4, i16 = lane & 15;
    const int qcol = (NS == 1 ? OFF_QA : OFF_QC) + h * 128;
    const int kcol = (NS == 1 ? OFF_KA + (h / 3) * 128 : OFF_KC + h * 128);
    const int vcol = (NS == 1 ? OFF_VA + (h / 3) * 128 : OFF_VC + h * 128);
    const int tq = qb * 128 + wave * 16 + i16;
    const gbf* rowbase = proj + (size_t)b * T * IN_W;
    bf16x8 qf[4];
#pragma unroll
    for (int kk = 0; kk < 4; ++kk) qf[kk] = *(const GAS bf16x8*)(rowbase + (size_t)tq * IN_W + qcol + kk * 32 + 8 * g);
    int jlo, jhi, kbase;
    if (NS == 1) { kbase = qb * 128 - 128; jlo = (qb == 0) ? 2 : 0; jhi = (qb == T / 128 - 1) ? 4 : 6; } else { kbase = 0; jlo = 0; jhi = T / 64; }
    const float c1 = (NS == 1 ? 0.08838834764831845f : 0.125f) * LOG2E;
    f32x4 O[NS][8]; float mrun[NS], lrun[NS];
#pragma unroll
    for (int s = 0; s < NS; ++s) { mrun[s] = (NS == 1) ? sink2 : -1e30f; lrun[s] = (NS == 1 && g == 0) ? 1.0f : 0.0f;
#pragma unroll
        for (int dt = 0; dt < 8; ++dt) O[s][dt] = (f32x4){0.f, 0.f, 0.f, 0.f}; }
    const int skey = tid >> 4, sch = tid & 15;
    u32x4 kreg[2], vreg[2];
    auto gload = [&](int j) { const int kp0 = kbase + 64 * j;
#pragma unroll
        for (int i = 0; i < 2; ++i) { const gbf* rp = rowbase + (size_t)(kp0 + skey + 32 * i) * IN_W + sch * 8;
            kreg[i] = *(const GAS u32x4*)(rp + kcol); vreg[i] = *(const GAS u32x4*)(rp + vcol); } };
    auto lstore = [&](int buf) { LAS unsigned char* bp = lds + buf * AT_BUF + (skey) * AT_PITCH + sch * 16;
#pragma unroll
        for (int i = 0; i < 2; ++i) { *(LAS u32x4*)(bp + i * 32 * AT_PITCH) = kreg[i]; *(LAS u32x4*)(bp + AT_TILE + i * 32 * AT_PITCH) = vreg[i]; } };
    gload(jlo);
    __syncthreads();
    lstore(0);
    __syncthreads();
    const int koff = i16 * AT_PITCH + 16 * g;
    const int voff = AT_TILE + (4 * g + (i16 >> 2)) * AT_PITCH + (i16 & 3) * 8;
    float slo[4][4];
#pragma unroll
    for (int kt = 0; kt < 4; ++kt)
#pragma unroll
        for (int r = 0; r < 4; ++r) slo[kt][r] = slope2 * (float)(kt * 16 + 4 * g + r);
    const int tqw = qb * 128 + wave * 16;
    constexpr float THR = 8.0f;
    for (int j = jlo; j < jhi; ++j) {
        const int buf = (j - jlo) & 1;
        if (j + 1 < jhi) gload(j + 1);
        LAS unsigned char* bp = lds + buf * AT_BUF;
        const int kp0 = kbase + 64 * j;
        f32x4 st[NS][4];
#pragma unroll
        for (int s = 0; s < NS; ++s)
#pragma unroll
            for (int kt = 0; kt < 4; ++kt) { st[s][kt] = (f32x4){0.f, 0.f, 0.f, 0.f};
#pragma unroll
                for (int kk = 0; kk < 4 / NS; ++kk) { const int kq = s * (4 / NS) + kk;
                    const bf16x8 kf = *(const LAS bf16x8*)(bp + koff + kt * 16 * AT_PITCH + kq * 64);
                    st[s][kt] = __builtin_amdgcn_mfma_f32_16x16x32_bf16(kf, qf[kq], st[s][kt], 0, 0, 0); } }
        f32x4 B[4];
        const float d0 = (float)(tq - kp0);
        if (kp0 + 63 <= tqw) {
            const float c0 = -slope2 * d0;
#pragma unroll
            for (int kt = 0; kt < 4; ++kt)
#pragma unroll
                for (int r = 0; r < 4; ++r) B[kt][r] = c0 + slo[kt][r];
        } else if (kp0 >= tqw + 15) {
            const float c0 = slope2 * d0;
#pragma unroll
            for (int kt = 0; kt < 4; ++kt)
#pragma unroll
                for (int r = 0; r < 4; ++r) B[kt][r] = c0 - slo[kt][r];
        } else {
#pragma unroll
            for (int kt = 0; kt < 4; ++kt)
#pragma unroll
                for (int r = 0; r < 4; ++r) { const float ad = fabsf(d0 - (float)(kt * 16 + 4 * g + r)); float bb = -slope2 * ad; if (NS == 1) bb = (ad <= 128.0f) ? bb : -1e30f; B[kt][r] = bb; }
        }
        if (NS == 1 && (kp0 + 63 <= tqw || kp0 >= tqw + 15)) {
#pragma unroll
            for (int kt = 0; kt < 4; ++kt)
#pragma unroll
                for (int r = 0; r < 4; ++r) { const float ad = fabsf(d0 - (float)(kt * 16 + 4 * g + r)); B[kt][r] = (ad <= 128.0f) ? B[kt][r] : -1e30f; }
        }
        bf16x8 pf[NS][2];
#pragma unroll
        for (int s = 0; s < NS; ++s) {
            float tmax = -1e30f;
#pragma unroll
            for (int kt = 0; kt < 4; ++kt) {
#pragma unroll
                for (int r = 0; r < 4; ++r) st[s][kt][r] = fmaf(st[s][kt][r], c1, B[kt][r]);
                tmax = fmaxf(tmax, fmaxf(fmaxf(st[s][kt][0], st[s][kt][1]), fmaxf(st[s][kt][2], st[s][kt][3]))); }
            if (__any(tmax > mrun[s] + THR)) {
                tmax = fmaxf(tmax, __shfl_xor(tmax, 16)); tmax = fmaxf(tmax, __shfl_xor(tmax, 32));
                const float mnew = fmaxf(mrun[s], tmax), alpha = __builtin_amdgcn_exp2f(mrun[s] - mnew); mrun[s] = mnew;
                lrun[s] *= alpha;
#pragma unroll
                for (int dt = 0; dt < 8; ++dt) O[s][dt] *= alpha;
            }
            const float mcur = mrun[s];
            float psum = 0.f;
#pragma unroll
            for (int kt = 0; kt < 4; ++kt)
#pragma unroll
                for (int r = 0; r < 4; ++r) { const float p = __builtin_amdgcn_exp2f(st[s][kt][r] - mcur); st[s][kt][r] = p; psum += p; }
            lrun[s] += psum;
#pragma unroll
            for (int k2 = 0; k2 < 2; ++k2) { u32x4 w; w.x = cvt_pk_bf16(st[s][2 * k2][0], st[s][2 * k2][1]); w.y = cvt_pk_bf16(st[s][2 * k2][2], st[s][2 * k2][3]);
                w.z = cvt_pk_bf16(st[s][2 * k2 + 1][0], st[s][2 * k2 + 1][1]); w.w = cvt_pk_bf16(st[s][2 * k2 + 1][2], st[s][2 * k2 + 1][3]); pf[s][k2] = __builtin_bit_cast(bf16x8, w); }
        }
#pragma unroll
        for (int dt = 0; dt < 8; ++dt)
#pragma unroll
            for (int k2 = 0; k2 < 2; ++k2) {
                const s16x4 lo = __builtin_bit_cast(s16x4, __builtin_amdgcn_ds_read_tr16_b64_v4i16((LAS s16x4*)(bp + voff + (k2 * 32) * AT_PITCH + dt * 32)));
                const s16x4 hi = __builtin_bit_cast(s16x4, __builtin_amdgcn_ds_read_tr16_b64_v4i16((LAS s16x4*)(bp + voff + (k2 * 32 + 16) * AT_PITCH + dt * 32)));
                const bf16x8 vf = {lo[0], lo[1], lo[2], lo[3], hi[0], hi[1], hi[2], hi[3]};
#pragma unroll
                for (int s = 0; s < NS; ++s) O[s][dt] = __builtin_amdgcn_mfma_f32_16x16x32_bf16(vf, pf[s][k2], O[s][dt], 0, 0, 0);
            }
        if (j + 1 < jhi) lstore(buf ^ 1);
        __syncthreads();
    }
    float inv[NS];
#pragma unroll
    for (int s = 0; s < NS; ++s) { float l = lrun[s]; l += __shfl_xor(l, 16); l += __shfl_xor(l, 32); inv[s] = 1.0f / l; }
    const int orow_r = b * T + tq, ocol = (NS == 1 ? 0 : MIX_C) + h * 128 + 4 * g;
    if (NS == 1) {
#pragma unroll
        for (int dt = 0; dt < 8; ++dt) { const f32x4 o = O[0][dt] * inv[0]; u32x2 w; w.x = cvt_pk_bf16(o[0], o[1]); w.y = cvt_pk_bf16(o[2], o[3]); *(GAS u32x2*)((guc*)mix + pg8::atile_off(orow_r, ocol + 16 * dt, D / 64)) = w; }
    } else {
        float ss = 0.f;
#pragma unroll
        for (int dt = 0; dt < 8; ++dt) { O[0][dt] = O[0][dt] * inv[0] - (O[NS - 1][dt] * inv[NS - 1]) * lam; const f32x4 o = O[0][dt]; ss += (o[0] * o[0] + o[1] * o[1]) + (o[2] * o[2] + o[3] * o[3]); }
        ss += __shfl_xor(ss, 16); ss += __shfl_xor(ss, 32);
        const float rs = rsqrtf(ss * (1.0f / 128.0f) + SUBLN_EPS) * outscale;
#pragma unroll
        for (int dt = 0; dt < 8; ++dt) { const f32x4 gv = *(const GAS f32x4*)(subg + 16 * dt + 4 * g); const f32x4 o = O[0][dt] * rs * gv;
            u32x2 w; w.x = cvt_pk_bf16(o[0], o[1]); w.y = cvt_pk_bf16(o[2], o[3]); *(GAS u32x2*)((guc*)mix + pg8::atile_off(orow_r, ocol + 16 * dt, D / 64)) = w; }
    }
}


constexpr int NTC = T / 64;
__device__ __forceinline__ void attn_c_fast(LAS unsigned char* lds, const gbf* __restrict__ proj, gbf* __restrict__ mix, int b, int h, int qb,
                                            float slope2, float lam, const gfl* __restrict__ subg, float outscale, float kmax2_0, float kmax2_1) {
    const int tid = fresh_tid(), wave = __builtin_amdgcn_readfirstlane(tid >> 6), lane = tid & 63, g = lane >> 4, i16 = lane & 15;
    const int qcol = OFF_QC + h * 128, kcol = OFF_KC + h * 128, vcol = OFF_VC + h * 128;
    const int tq = qb * 128 + wave * 16 + i16, tqw = qb * 128 + wave * 16;
    const gbf* rowbase = proj + (size_t)b * T * IN_W;
    const float c1 = 0.125f * LOG2E;
    bf16x8 qf[4];
#pragma unroll
    for (int kk = 0; kk < 4; ++kk) qf[kk] = *(const GAS bf16x8*)(rowbase + (size_t)tq * IN_W + qcol + kk * 32 + 8 * g);
    float mref[2];
#pragma unroll
    for (int s = 0; s < 2; ++s) { float ss = 0.f;
#pragma unroll
        for (int kk = 0; kk < 2; ++kk)
#pragma unroll
            for (int e = 0; e < 8; ++e) { const float v = __uint_as_float(((unsigned)(unsigned short)qf[2 * s + kk][e]) << 16); ss += v * v; }
        ss += __shfl_xor(ss, 16); ss += __shfl_xor(ss, 32);
        mref[s] = c1 * sqrtf(ss * (s == 0 ? kmax2_0 : kmax2_1)) + 1.0f; }
    float slo[4][4];
#pragma unroll
    for (int kt = 0; kt < 4; ++kt)
#pragma unroll
        for (int r = 0; r < 4; ++r) slo[kt][r] = (float)(kt * 16 + 4 * g + r);
    f32x4 O[2][8]; float lrun[2] = {0.f, 0.f};
#pragma unroll
    for (int s = 0; s < 2; ++s)
#pragma unroll
        for (int dt = 0; dt < 8; ++dt) O[s][dt] = (f32x4){0.f, 0.f, 0.f, 0.f};
    const int skey = tid >> 4, sch = tid & 15;
    u32x4 kreg[2], vreg[2];
    const gbf* sbase = rowbase + (size_t)skey * IN_W + sch * 8;
    LAS unsigned char* sdst = lds + skey * AT_PITCH + sch * 16;
#define C_GLOADK(j) do { _Pragma("unroll") for (int i_ = 0; i_ < 2; ++i_) kreg[i_] = *(const GAS u32x4*)(sbase + (size_t)(64 * (j) + 32 * i_) * IN_W + kcol); } while (0)
#define C_GLOADV(j) do { _Pragma("unroll") for (int i_ = 0; i_ < 2; ++i_) vreg[i_] = *(const GAS u32x4*)(sbase + (size_t)(64 * (j) + 32 * i_) * IN_W + vcol); } while (0)
#define C_LSTK(bi) do { _Pragma("unroll") for (int i_ = 0; i_ < 2; ++i_) *(LAS u32x4*)(sdst + (bi) * AT_TILE + i_ * 32 * AT_PITCH) = kreg[i_]; } while (0)
#define C_LSTV(bi) do { _Pragma("unroll") for (int i_ = 0; i_ < 2; ++i_) *(LAS u32x4*)(sdst + (2 + (bi)) * AT_TILE + i_ * 32 * AT_PITCH) = vreg[i_]; } while (0)
    const int koff = i16 * AT_PITCH + 16 * g;
    const int voff = 2 * AT_TILE + (4 * g + (i16 >> 2)) * AT_PITCH + (i16 & 3) * 8;
    u32x4 k1reg[2];
    C_GLOADK(0); C_GLOADV(0);
#pragma unroll
    for (int i_ = 0; i_ < 2; ++i_) k1reg[i_] = *(const GAS u32x4*)(sbase + (size_t)(64 + 32 * i_) * IN_W + kcol);
#define C_S(kb, stx) do { \
        _Pragma("unroll") for (int s_ = 0; s_ < 2; ++s_) _Pragma("unroll") for (int kt_ = 0; kt_ < 4; ++kt_) { stx[s_][kt_] = (f32x4){0.f, 0.f, 0.f, 0.f}; \
            _Pragma("unroll") for (int kk_ = 0; kk_ < 2; ++kk_) { const bf16x8 kf_ = *(const LAS bf16x8*)(lds + (kb) * AT_TILE + koff + kt_ * 16 * AT_PITCH + (2 * s_ + kk_) * 64); \
                stx[s_][kt_] = __builtin_amdgcn_mfma_f32_16x16x32_bf16(kf_, qf[2 * s_ + kk_], stx[s_][kt_], 0, 0, 0); } } \
    } while (0)
#define C_EXP(t, stx, pfo) do { \
        const float d0_ = (float)(tq - 64 * (t)); f32x4 B_[4]; \
        _Pragma("unroll") for (int kt_ = 0; kt_ < 4; ++kt_) _Pragma("unroll") for (int r_ = 0; r_ < 4; ++r_) B_[kt_][r_] = fabsf(d0_ - slo[kt_][r_]);     \
        _Pragma("unroll") for (int s_ = 0; s_ < 2; ++s_) { float ps_ = 0.f; const float nm_ = -mref[s_]; \
            _Pragma("unroll") for (int kt_ = 0; kt_ < 4; ++kt_) _Pragma("unroll") for (int r_ = 0; r_ < 4; ++r_) { const float p_ = __builtin_amdgcn_exp2f(fmaf(stx[s_][kt_][r_], c1, fmaf(-slope2, B_[kt_][r_], nm_))); stx[s_][kt_][r_] = p_; ps_ += p_; } \
            lrun[s_] += ps_; \
            _Pragma("unroll") for (int k2_ = 0; k2_ < 2; ++k2_) { u32x4 w_; w_.x = cvt_pk_bf16(stx[s_][2 * k2_][0], stx[s_][2 * k2_][1]); w_.y = cvt_pk_bf16(stx[s_][2 * k2_][2], stx[s_][2 * k2_][3]); \
                w_.z = cvt_pk_bf16(stx[s_][2 * k2_ + 1][0], stx[s_][2 * k2_ + 1][1]); w_.w = cvt_pk_bf16(stx[s_][2 * k2_ + 1][2], stx[s_][2 * k2_ + 1][3]); pfo[s_][k2_] = __builtin_bit_cast(bf16x8, w_); } } \
    } while (0)
#define C_PV(vb, pfi) do { \
        _Pragma("unroll") for (int dt_ = 0; dt_ < 8; ++dt_) _Pragma("unroll") for (int k2_ = 0; k2_ < 2; ++k2_) { \
            const s16x4 lo_ = __builtin_bit_cast(s16x4, __builtin_amdgcn_ds_read_tr16_b64_v4i16((LAS s16x4*)(lds + (vb) * AT_TILE + voff + (k2_ * 32) * AT_PITCH + dt_ * 32))); \
            const s16x4 hi_ = __builtin_bit_cast(s16x4, __builtin_amdgcn_ds_read_tr16_b64_v4i16((LAS s16x4*)(lds + (vb) * AT_TILE + voff + (k2_ * 32 + 16) * AT_PITCH + dt_ * 32))); \
            const bf16x8 vf_ = {lo_[0], lo_[1], lo_[2], lo_[3], hi_[0], hi_[1], hi_[2], hi_[3]}; \
            _Pragma("unroll") for (int s_ = 0; s_ < 2; ++s_) O[s_][dt_] = __builtin_amdgcn_mfma_f32_16x16x32_bf16(vf_, pfi[s_][k2_], O[s_][dt_], 0, 0, 0); } \
    } while (0)
    __syncthreads();
    C_LSTK(0); C_LSTV(0);
#pragma unroll
    for (int i_ = 0; i_ < 2; ++i_) *(LAS u32x4*)(sdst + 1 * AT_TILE + i_ * 32 * AT_PITCH) = k1reg[i_];
    __syncthreads();
    bf16x8 pf[2][2], pfn[2][2];
    { f32x4 st0[2][4]; C_S(0, st0); C_EXP(0, st0, pf); }
    __syncthreads();
#pragma nounroll
    for (int j = 0; j < NTC - 1; ++j) {
        const int jk = (j + 2 < NTC) ? j + 2 : NTC - 1;
        C_GLOADK(jk); C_GLOADV(j + 1);
        const LAS unsigned char* kbp = lds + ((j + 1) & 1) * AT_TILE + koff;
        const LAS unsigned char* vbp = lds + (j & 1) * AT_TILE + voff;
        f32x4 stn[2][4]; bf16x8 kfr[3][4], vfr[3][2];
#define C_LDK(kt, bi) do { _Pragma("unroll") for (int q_ = 0; q_ < 4; ++q_) kfr[bi][q_] = *(const LAS bf16x8*)(kbp + (kt) * 16 * AT_PITCH + q_ * 64); } while (0)
#define C_LDV(dt, bi) do { _Pragma("unroll") for (int k2_ = 0; k2_ < 2; ++k2_) { \
            const s16x4 lo_ = __builtin_bit_cast(s16x4, __builtin_amdgcn_ds_read_tr16_b64_v4i16((LAS s16x4*)(vbp + (k2_ * 32) * AT_PITCH + (dt) * 32))); \
            const s16x4 hi_ = __builtin_bit_cast(s16x4, __builtin_amdgcn_ds_read_tr16_b64_v4i16((LAS s16x4*)(vbp + (k2_ * 32 + 16) * AT_PITCH + (dt) * 32))); \
            vfr[bi][k2_] = (bf16x8){lo_[0], lo_[1], lo_[2], lo_[3], hi_[0], hi_[1], hi_[2], hi_[3]}; } } while (0)
        C_LDK(0, 0); C_LDK(1, 1);
#pragma unroll
        for (int kt = 0; kt < 4; ++kt) {
            __builtin_amdgcn_sched_barrier(0);
            if (kt < 2) C_LDK(kt + 2, (kt + 2) % 3); else C_LDV(kt - 2, kt - 2);
#pragma unroll
            for (int s_ = 0; s_ < 2; ++s_) { stn[s_][kt] = (f32x4){0.f, 0.f, 0.f, 0.f};
#pragma unroll
                for (int kk = 0; kk < 2; ++kk) stn[s_][kt] = __builtin_amdgcn_mfma_f32_16x16x32_bf16(kfr[kt % 3][2 * s_ + kk], qf[2 * s_ + kk], stn[s_][kt], 0, 0, 0); }
        }
        const float dq = (float)(tq - 64 * (j + 1) - 4 * g);
        float ps0 = 0.f, ps1 = 0.f; const float nm0 = -mref[0], nm1 = -mref[1];
#pragma unroll
        for (int dt = 0; dt < 8; ++dt) {
            __builtin_amdgcn_sched_barrier(0);
            if (dt < 6) C_LDV(dt + 2, (dt + 2) % 3);
#pragma unroll
            for (int k2 = 0; k2 < 2; ++k2)
#pragma unroll
                for (int s_ = 0; s_ < 2; ++s_) O[s_][dt] = __builtin_amdgcn_mfma_f32_16x16x32_bf16(vfr[dt % 3][k2], pf[s_][k2], O[s_][dt], 0, 0, 0);
#pragma unroll
            for (int rr = 0; rr < 2; ++rr) { const int kt = dt >> 1, r = 2 * (dt & 1) + rr; const float bb = -slope2 * fabsf(dq - (float)(kt * 16 + r));
                const float p0 = __builtin_amdgcn_exp2f(fmaf(stn[0][kt][r], c1, bb + nm0)), p1 = __builtin_amdgcn_exp2f(fmaf(stn[1][kt][r], c1, bb + nm1));
                stn[0][kt][r] = p0; stn[1][kt][r] = p1; ps0 += p0; ps1 += p1; }
        }
        __builtin_amdgcn_sched_barrier(0);
#undef C_LDK
#undef C_LDV
        lrun[0] += ps0; lrun[1] += ps1;
#pragma unroll
        for (int s_ = 0; s_ < 2; ++s_)
#pragma unroll
            for (int k2 = 0; k2 < 2; ++k2) { u32x4 w_; w_.x = cvt_pk_bf16(stn[s_][2 * k2][0], stn[s_][2 * k2][1]); w_.y = cvt_pk_bf16(stn[s_][2 * k2][2], stn[s_][2 * k2][3]);
                w_.z = cvt_pk_bf16(stn[s_][2 * k2 + 1][0], stn[s_][2 * k2 + 1][1]); w_.w = cvt_pk_bf16(stn[s_][2 * k2 + 1][2], stn[s_][2 * k2 + 1][3]); pfn[s_][k2] = __builtin_bit_cast(bf16x8, w_); }
        C_LSTK(j & 1); C_LSTV((j + 1) & 1);
        __syncthreads();
#pragma unroll
        for (int s = 0; s < 2; ++s)
#pragma unroll
            for (int k2 = 0; k2 < 2; ++k2) pf[s][k2] = pfn[s][k2];
    }
    C_PV((NTC - 1) & 1, pf);
#undef C_GLOADK
#undef C_GLOADV
#undef C_LSTK
#undef C_LSTV
#undef C_S
#undef C_EXP
#undef C_PV
    float inv[2];
#pragma unroll
    for (int s = 0; s < 2; ++s) { float l = lrun[s]; l += __shfl_xor(l, 16); l += __shfl_xor(l, 32); inv[s] = 1.0f / l; }
    const int orow_r = b * T + tq, ocol = MIX_C + h * 128 + 4 * g;
    float ss = 0.f;
#pragma unroll
    for (int dt = 0; dt < 8; ++dt) { O[0][dt] = O[0][dt] * inv[0] - (O[1][dt] * inv[1]) * lam; const f32x4 o = O[0][dt]; ss += (o[0] * o[0] + o[1] * o[1]) + (o[2] * o[2] + o[3] * o[3]); }
    ss += __shfl_xor(ss, 16); ss += __shfl_xor(ss, 32);
    const float rs = rsqrtf(ss * (1.0f / 128.0f) + SUBLN_EPS) * outscale;
#pragma unroll
    for (int dt = 0; dt < 8; ++dt) { const f32x4 gv = *(const GAS f32x4*)(subg + 16 * dt + 4 * g); const f32x4 o = O[0][dt] * rs * gv;
        u32x2 w; w.x = cvt_pk_bf16(o[0], o[1]); w.y = cvt_pk_bf16(o[2], o[3]); *(GAS u32x2*)((guc*)mix + pg8::atile_off(orow_r, ocol + 16 * dt, D / 64)) = w; }
}

__device__ __forceinline__ void transpose_item(const gfl* __restrict__ W, int N, int k0, int n0, guc* __restrict__ dimg, int r0, int nkt, LAS float* scr, int lane) {
#pragma unroll 8
    for (int i = 0; i < 32; ++i) { const int kk = 2 * i + (lane >> 5); scr[kk * 33 + (lane & 31)] = W[(size_t)(k0 + kk) * N + n0 + (lane & 31)]; }
    LDS_WAIT(); asm volatile("" ::: "memory");
    const int c = lane & 7;
#pragma unroll
    for (int j = 0; j < 4; ++j) { const int n = (lane >> 3) + 8 * j; const LAS float* s = scr + (8 * c) * 33 + n;
        u32x4 o; o.x = cvt_pk_bf16(s[0 * 33], s[1 * 33]); o.y = cvt_pk_bf16(s[2 * 33], s[3 * 33]); o.z = cvt_pk_bf16(s[4 * 33], s[5 * 33]); o.w = cvt_pk_bf16(s[6 * 33], s[7 * 33]);
        *(GAS u32x4*)(dimg + pg8::btile_off(r0 + n, k0 >> 6, c, nkt)) = o; }
    LDS_WAIT(); asm volatile("" ::: "memory");
}

__device__ __forceinline__ void acc8(float (&s)[8], u32x4 w, float sg) {
    asm volatile("" : "+v"(w));
    s[0] += sg * bf_lo(w.x); s[1] += sg * bf_hi(w.x); s[2] += sg * bf_lo(w.y); s[3] += sg * bf_hi(w.y); s[4] += sg * bf_lo(w.z); s[5] += sg * bf_hi(w.z); s[6] += sg * bf_lo(w.w); s[7] += sg * bf_hi(w.w);
}
template <int R>
__device__ __forceinline__ void stencil_block(const gbf* __restrict__ up, int t0, guc* __restrict__ zimg, int m0, int ch) {
    guc* zlo = zimg + pg8::atile_off(m0, ch * 8, POOLW / 64); guc* zhi = zimg + pg8::atile_off(m0 + 8, ch * 8, POOLW / 64);
    u32x4 wv[16 + 2 * R];
#pragma unroll
    for (int k = 0; k < 16 + 2 * R; ++k) { const int q = t0 - R + k; const bool ok = (q >= 0) && (q < T); wv[k] = *(const GAS u32x4*)(up + (size_t)(ok ? q : t0) * IN_W); }
    __builtin_amdgcn_sched_barrier(0);
#pragma unroll
    for (int k = 0; k < 16 + 2 * R; ++k) { const int q = t0 - R + k; const bool ok = (q >= 0) && (q < T); if (!ok) wv[k] = (u32x4){0u, 0u, 0u, 0u}; }
    float s[8];
#pragma unroll
    for (int j = 0; j < 8; ++j) s[j] = 0.f;
#pragma unroll
    for (int k = 0; k < 2 * R + 1; ++k) acc8(s, wv[k], 1.0f);
#pragma unroll
    for (int i = 0; i < 16; ++i) {
        const int t = t0 + i, tlo = (t - R < 0) ? 0 : t - R, thi = (t + R + 1 > T) ? T : t + R + 1; const float ic = __builtin_amdgcn_rcpf((float)(thi - tlo));
        u32x4 w = wv[R + i]; asm volatile("" : "+v"(w));
        u32x4 o; o.x = cvt_pk_bf16(s[0] * ic - bf_lo(w.x), s[1] * ic - bf_hi(w.x)); o.y = cvt_pk_bf16(s[2] * ic - bf_lo(w.y), s[3] * ic - bf_hi(w.y));
        o.z = cvt_pk_bf16(s[4] * ic - bf_lo(w.z), s[5] * ic - bf_hi(w.z)); o.w = cvt_pk_bf16(s[6] * ic - bf_lo(w.w), s[7] * ic - bf_hi(w.w));
        *(GAS u32x4*)((i < 8 ? zlo : zhi) + (i & 7) * 64) = o;
        if (i < 15) { acc8(s, wv[i + 2 * R + 1], 1.0f); acc8(s, wv[i], -1.0f); }
    }
}

struct Args { const float* in[21]; float* out; unsigned char* ws; int ph_lo, ph_hi; };
enum { I_X = 0, I_C, I_ADAW, I_ADAB, I_MPRE, I_MPOST, I_WIN, I_SINK, I_POOLW, I_PSCALE, I_LAMBDA, I_SUBG, I_WGATE, I_BGATE, I_WBRANCH, I_WOUT, I_FPRE, I_FPOST, I_FWG, I_FWU, I_FWD };

template <bool SRC_BF, bool DST_BF>
__device__ __forceinline__ void rownorm_phase(const void GAS* xsrc_, void GAS* xdst_, const gbf* y, const gfl* gpost, const gfl* gate,
                                              const gfl* gpre, const gfl* shift, const gfl* scale, gbf* hdst, int bx, int G, LAS unsigned char* lds) {
    const int tid = fresh_tid(), lane = tid & 63, wave = __builtin_amdgcn_readfirstlane(tid >> 6);
    const bool al = (G & 7) == 0;
    const int b0 = al ? (bx & 7) : 0, bstep = al ? 8 : 1, cb = al ? (bx >> 3) : bx, nb = al ? (G >> 3) : G;
    LAS float* pa = (LAS float*)lds; LAS float* pb = pa + D; LAS float* pc = pb + D;
    for (int b = b0; b < BATCH; b += bstep) {
        __syncthreads();
        { const int c0 = tid * 8;
#pragma unroll
          for (int q = 0; q < 2; ++q) { const int c = c0 + 4 * q;
            if (y) { const f32x4 g = *(const GAS f32x4*)(gate + (size_t)b * ADA + c), p = *(const GAS f32x4*)(gpost + c); *(LAS f32x4*)(pa + c) = g * p; }
            if (hdst) { const f32x4 p = *(const GAS f32x4*)(gpre + c), sc = *(const GAS f32x4*)(scale + (size_t)b * ADA + c), sh = *(const GAS f32x4*)(shift + (size_t)b * ADA + c);
                *(LAS f32x4*)(pb + c) = p * (1.0f + sc); *(LAS f32x4*)(pc + c) = sh; } } }
        __syncthreads();
        constexpr int NR = SRC_BF ? 2 : 1;
        constexpr int QS = 8;
        for (int r = cb * 8 * NR + wave; r < T; r += NR * nb * 8) {
            u32x2 xw[NR][16], yw[NR][16]; f32x4 xf[SRC_BF ? 1 : 16];
#pragma unroll
            for (int q = 0; q < NR; ++q) { const int rq = (r + q * QS < T) ? r + q * QS : r; const int m = b * T + rq; const size_t ro = (size_t)m * D + 4 * lane;
                if constexpr (SRC_BF) {
#pragma unroll
                    for (int j = 0; j < 16; ++j) xw[q][j] = __builtin_nontemporal_load((const GAS u32x2*)((const gbf*)xsrc_ + ro + 256 * j));
                } else {
#pragma unroll
                    for (int j = 0; j < 16; ++j) xf[j] = *(const GAS f32x4*)((const gfl*)xsrc_ + ro + 256 * j);
                }
                if (y) {
#pragma unroll
                    for (int j = 0; j < 16; ++j) yw[q][j] = __builtin_nontemporal_load((const GAS u32x2*)((const guc*)y + pg8::atile_off(m, 4 * lane + 256 * j, D / 64)));
                } }
#pragma unroll
            for (int q = 0; q < NR; ++q) {
                if (r + q * QS >= T) break;
                const int m = b * T + r + q * QS; const size_t ro = (size_t)m * D + 4 * lane;
                f32x4 xv[16];
#pragma unroll
                for (int j = 0; j < 16; ++j) { if constexpr (SRC_BF) xv[j] = (f32x4){bf_lo(xw[q][j].x), bf_hi(xw[q][j].x), bf_lo(xw[q][j].y), bf_hi(xw[q][j].y)}; else xv[j] = xf[j]; }
                if (y) {
                    float ss = 0.f;
#pragma unroll
                    for (int j = 0; j < 16; ++j) { const f32x4 yv = {bf_lo(yw[q][j].x), bf_hi(yw[q][j].x), bf_lo(yw[q][j].y), bf_hi(yw[q][j].y)}; ss += (yv[0] * yv[0] + yv[1] * yv[1]) + (yv[2] * yv[2] + yv[3] * yv[3]); }
                    const float rstd = rsqrtf(wave_sum(ss) * (1.0f / D) + NORM_EPS);
#pragma unroll
                    for (int j = 0; j < 16; ++j) { const f32x4 av = *(const LAS f32x4*)(pa + 4 * lane + 256 * j);
                        const f32x4 yv = {bf_lo(yw[q][j].x), bf_hi(yw[q][j].x), bf_lo(yw[q][j].y), bf_hi(yw[q][j].y)};
                        xv[j] += av * (yv * rstd);
                        if constexpr (DST_BF) { u32x2 w; w.x = cvt_pk_bf16(xv[j][0], xv[j][1]); w.y = cvt_pk_bf16(xv[j][2], xv[j][3]); *(GAS u32x2*)((gbf*)xdst_ + ro + 256 * j) = w;
                            xv[j] = (f32x4){bf_lo(w.x), bf_hi(w.x), bf_lo(w.y), bf_hi(w.y)}; }
                        else *(GAS f32x4*)((gfl*)xdst_ + ro + 256 * j) = xv[j];
                        if ((j & 3) == 3) asm volatile("" ::: "memory"); }
                }
                if (hdst) {
                    float ss = 0.f;
#pragma unroll
                    for (int j = 0; j < 16; ++j) ss += (xv[j][0] * xv[j][0] + xv[j][1] * xv[j][1]) + (xv[j][2] * xv[j][2] + xv[j][3] * xv[j][3]);
                    const float rstd = rsqrtf(wave_sum(ss) * (1.0f / D) + NORM_EPS);
#pragma unroll
                    for (int j = 0; j < 16; ++j) { const f32x4 bv = *(const LAS f32x4*)(pb + 4 * lane + 256 * j), cv = *(const LAS f32x4*)(pc + 4 * lane + 256 * j);
                        const f32x4 hv = (xv[j] * rstd) * bv + cv; u32x2 w; w.x = cvt_pk_bf16(hv[0], hv[1]); w.y = cvt_pk_bf16(hv[2], hv[3]); *(GAS u32x2*)((guc*)hdst + pg8::atile_off(m, 4 * lane + 256 * j, D / 64)) = w;
                        if ((j & 3) == 3) asm volatile("" ::: "memory"); }
                }
            }
        }
    }
    __syncthreads();
}

__global__ void __launch_bounds__(512, 2) fwd(Args a) {
    extern __shared__ __attribute__((aligned(16))) unsigned char lds_raw[];
    LAS unsigned char* lds = (LAS unsigned char*)lds_raw;
    unsigned* ctl = (unsigned*)(a.ws + WS_CTL);
    volatile LAS unsigned* MISC = (volatile LAS unsigned*)(lds + MISC_OFF);
    for (int u = threadIdx.x; u < (LDS_BYTES - LDSCTL_OFF) / 4; u += 512) ((LAS unsigned*)(lds + LDSCTL_OFF))[u] = 0u;
    __syncthreads();
    const int lo = a.ph_lo, hi = a.ph_hi;
    XcdBarrier bar; bar.bar = ctl + CW_BAR; bar.x = 0; bar.st = nullptr;
    if (hi - lo > 1) bar = xcd_barrier_post(ctl + CW_BAR, MISC + 8);
#define IN(k) (lo <= (k) && (k) < hi)
#define SEAM(k) do { if (IN(k) && IN((k) + 1)) xcd_barrier(bar); } while (0)
#define INP(k) ((const gfl*)a.in[opq(k)])
#define WSB ((guc*)opqp(a.ws))
#define MODP ((gfl*)(WSB + WS_MOD))
#define HB ((gbf*)(WSB + WS_H))
#define MIXP ((gbf*)(WSB + WS_MIX))
#define MERGP ((gbf*)(WSB + WS_MERG))
#define YB ((gbf*)(WSB + WS_Y))
#define XBP ((gbf*)(WSB + WS_M32))
#define ZB ((gbf*)(WSB + WS_Z))
#define PROJP ((gbf*)(WSB + WS_PROJ))
#define GATESP ((gbf*)(WSB + WS_GATES))
#define HIDP ((gbf*)(WSB + WS_HID))
#define WLAYER(l) (WSB + WS_W + (size_t)(l) * W_LAYER)
#define GEOM() const int G = opq((int)gridDim.x), bx = opq((int)blockIdx.x), vcu = (G % 8 == 0) ? (bx % 8) * (G / 8) + bx / 8 : bx; (void)vcu

    if (IN(0)) {
        GEOM();
        {
            LAS float* cond = (LAS float*)lds;
            const int tid = fresh_tid();
            const int cq = tid % 24, kg = tid / 24;
            const gfl* cin = INP(I_C); const gfl* adaw = INP(I_ADAW); const gfl* adab = INP(I_ADAB); gfl* mod = MODP;
            for (int slab = vcu; slab < DEPTH * ADA / 96; slab += G) {
                const int l = slab / (ADA / 96), col0 = (slab % (ADA / 96)) * 96;
                for (int i = tid; i < BATCH * D; i += 512) { const int b = i / D, k = i % D; const float v = cin[i]; cond[k * 8 + b] = v / (1.0f + __expf(-v)); }
                __syncthreads();
                float acc[8][4];
#pragma unroll
                for (int b = 0; b < 8; ++b)
#pragma unroll
                    for (int j = 0; j < 4; ++j) acc[b][j] = 0.f;
                if (kg < 21) {
                    const gfl* wp = adaw + (size_t)l * D * ADA + col0 + cq * 4;
#pragma unroll 4
                    for (int k = kg; k < D; k += 21) {
                        const f32x4 w = *(const GAS f32x4*)(wp + (size_t)k * ADA);
                        const f32x4 c0 = *(const LAS f32x4*)(cond + k * 8), c1 = *(const LAS f32x4*)(cond + k * 8 + 4);
#pragma unroll
                        for (int j = 0; j < 4; ++j) { acc[0][j] += c0[0] * w[j]; acc[1][j] += c0[1] * w[j]; acc[2][j] += c0[2] * w[j]; acc[3][j] += c0[3] * w[j];
                            acc[4][j] += c1[0] * w[j]; acc[5][j] += c1[1] * w[j]; acc[6][j] += c1[2] * w[j]; acc[7][j] += c1[3] * w[j]; }
                    }
                }
                __syncthreads();
                LAS float* part = (LAS float*)lds;
                if (kg < 21) {
#pragma unroll
                    for (int b = 0; b < 8; ++b) *(LAS f32x4*)(part + (kg * 8 + b) * 96 + cq * 4) = (f32x4){acc[b][0], acc[b][1], acc[b][2], acc[b][3]};
                }
                __syncthreads();
                for (int o = tid; o < 8 * 96; o += 512) { const int b = o / 96, cc = o % 96; float s = adab[(size_t)l * ADA + col0 + cc];
                    for (int q = 0; q < 21; ++q) s += part[(q * 8 + b) * 96 + cc];
                    mod[((size_t)l * BATCH + b) * ADA + col0 + cc] = s; }
                __syncthreads();
            }
        }
        {
            const int tid = fresh_tid(), lane = tid & 63, wave = __builtin_amdgcn_readfirstlane(tid >> 6), gw = vcu * 8 + wave, ngw = G * 8;
            LAS float* scr = (LAS float*)(lds + wave * 8448);
            constexpr int I_IN = 64 * (IN_W / 32), I_GT = 64 * (GATE_W / 32), I_BR = 64 * (D / 32), I_OUT = I_BR, I_FG = 64 * (FF / 32), I_FU = I_FG, I_FD = (FF / 64) * (D / 32), I_PW = 4 * 4 * 8;
            constexpr int PER_LAYER = I_IN + I_GT + I_BR + I_OUT + I_FG + I_FU + I_FD + I_PW;
            for (int it = gw; it < DEPTH * PER_LAYER; it += ngw) {
                const int l = it / PER_LAYER; int r = it - l * PER_LAYER;
                guc* wl = WLAYER(l);
                if (r < I_IN) { const int nb = r % (IN_W / 32), kb = r / (IN_W / 32);
                    transpose_item(INP(I_WIN) + (size_t)l * D * IN_W, IN_W, kb * 64, nb * 32, wl + W_1, nb * 32, D / 64, scr, lane); continue; } r -= I_IN;
                if (r < I_GT) { const int nb = r % (GATE_W / 32), kb = r / (GATE_W / 32);
                    transpose_item(INP(I_WGATE) + (size_t)l * D * GATE_W, GATE_W, kb * 64, nb * 32, wl + W_1, IN_W + nb * 32, D / 64, scr, lane); continue; } r -= I_GT;
                if (r < I_BR) { const int nb = r % (D / 32), kb = r / (D / 32);
                    transpose_item(INP(I_WBRANCH) + (size_t)l * D * D, D, kb * 64, nb * 32, wl + W_B, nb * 32, D / 64, scr, lane); continue; } r -= I_BR;
                if (r < I_OUT) { const int nb = r % (D / 32), kb = r / (D / 32);
                    transpose_item(INP(I_WOUT) + (size_t)l * D * D, D, kb * 64, nb * 32, wl + W_O, nb * 32, D / 64, scr, lane); continue; } r -= I_OUT;
                if (r < I_FG) { const int nb = r % (FF / 32), kb = r / (FF / 32); const int n0 = nb * 32, row = (n0 / 128) * 256 + (n0 % 128);
                    transpose_item(INP(I_FWG) + (size_t)l * D * FF, FF, kb * 64, n0, wl + W_F, row, D / 64, scr, lane); continue; } r -= I_FG;
                if (r < I_FU) { const int nb = r % (FF / 32), kb = r / (FF / 32); const int n0 = nb * 32, row = (n0 / 128) * 256 + 128 + (n0 % 128);
                    transpose_item(INP(I_FWU) + (size_t)l * D * FF, FF, kb * 64, n0, wl + W_F, row, D / 64, scr, lane); continue; } r -= I_FU;
                if (r < I_FD) { const int nb = r % (D / 32), kb = r / (D / 32);
                    transpose_item(INP(I_FWD) + (size_t)l * FF * D, D, kb * 64, nb * 32, wl + W_D, nb * 32, FF / 64, scr, lane); continue; } r -= I_FD;
                { const int gi = r / 32, rr = r % 32, nb = rr % 8, kb = rr / 8;
                    transpose_item(INP(I_POOLW) + ((size_t)l * 4 + gi) * 256 * 256, 256, kb * 64, nb * 32, WSB + WS_PWT + (size_t)l * 1024 * 256 * 2, gi * 256 + nb * 32, 4, scr, lane); }
            }
        }
    }
    SEAM(0);
    if (IN(1)) { GEOM(); const gfl* mod = MODP; rownorm_phase<false, true>(INP(I_X), (void GAS*)nullptr, (const gbf*)nullptr, (const gfl*)nullptr, (const gfl*)nullptr, INP(I_MPRE), mod + 0 * D, mod + 1 * D, HB, bx, G, lds); }
    SEAM(1);

#pragma nounroll
    for (int l = 0; l < DEPTH; ++l) {
        const int pb = 2 + 9 * l;
        if (IN(pb + 0)) {
            GEOM();
            typedef pg8::Prob<1, 0, 0, D / 64, 0, 0> PT; PT P{HB, (const gbf*)(WLAYER(l) + W_1), D / 64, D / 64, M / 256, N1 / 256, G, bx, 0, 0};
            pg8::EpiInGate E{PROJP, GATESP, INP(I_BGATE) + (size_t)l * GATE_W, (GAS unsigned*)(WSB + WS_CTL) + CW_NMAX + l * 1024};
            pg8::gemm_phase<pg8::EpiInGate, PT, true, true>(lds, P, E);
        }
        SEAM(pb + 0);
        const bool zlocal = (opq((int)gridDim.x) == (M / 256) * 4);
        if (IN(pb + 1) && !zlocal) {
            GEOM();
            const int tid = fresh_tid(); const gbf* proj = PROJP; gbf* zb = ZB;
            for (int it = (vcu * 512 + tid); it < M * 128; it += G * 512) {
                const int m = it >> 7, ch = it & 127, t = m % T, r = 1 << (ch >> 5);
                const int tlo = (t - r < 0) ? 0 : t - r, thi = (t + r + 1 > T) ? T : t + r + 1;
                const gbf* up = proj + (size_t)(m - t) * IN_W + OFF_U + ch * 8;
                float s[8];
#pragma unroll
                for (int j = 0; j < 8; ++j) s[j] = 0.f;
                u32x4 wv[17];
#pragma unroll
                for (int k = 0; k < 17; ++k) { const int q = t - 8 + k; const bool ok = (q >= tlo) && (q < thi); wv[k] = ok ? *(const GAS u32x4*)(up + (size_t)(ok ? q : t) * IN_W) : (u32x4){0u, 0u, 0u, 0u}; }
#pragma unroll
                for (int k = 0; k < 17; ++k) { const u32x4 w = wv[k];
                    s[0] += bf_lo(w.x); s[1] += bf_hi(w.x); s[2] += bf_lo(w.y); s[3] += bf_hi(w.y); s[4] += bf_lo(w.z); s[5] += bf_hi(w.z); s[6] += bf_lo(w.w); s[7] += bf_hi(w.w); }
                const u32x4 w = *(const GAS u32x4*)(up + (size_t)t * IN_W); const float ic = 1.0f / (float)(thi - tlo);
                u32x4 o; o.x = cvt_pk_bf16(s[0] * ic - bf_lo(w.x), s[1] * ic - bf_hi(w.x)); o.y = cvt_pk_bf16(s[2] * ic - bf_lo(w.y), s[3] * ic - bf_hi(w.y));
                o.z = cvt_pk_bf16(s[4] * ic - bf_lo(w.z), s[5] * ic - bf_hi(w.z)); o.w = cvt_pk_bf16(s[6] * ic - bf_lo(w.w), s[7] * ic - bf_hi(w.w));
                *(GAS u32x4*)((guc*)zb + pg8::atile_off(m, ch * 8, POOLW / 64)) = o;
            }
        }
        if (!zlocal) SEAM(pb + 1);
        if (IN(pb + 2)) {
            const float lam_init = (l == 0) ? 0.2f : (0.8f - 0.6f * 0.7408182206817179f);
            {
                GEOM();
                typedef pg8::Prob<1, 0, 0, 4, 0, 0> PT; PT P{ZB, (const gbf*)(WSB + WS_PWT) + (size_t)l * 1024 * 256, POOLW / 64, 4, M / 256, 4, G, bx, 256, 0};
                if (zlocal) {
                    pg8::Unit u0;
                    if (P.next(0, u0)) { const int tid = fresh_tid(), m0 = u0.pm * 256 + (tid >> 5) * 16, t0 = m0 % T, ch = u0.pn * 32 + (tid & 31);
                        const gbf* up = PROJP + (size_t)(m0 - t0) * IN_W + OFF_U + ch * 8; guc* zimg = (guc*)ZB;
                        if (u0.pn == 0) stencil_block<1>(up, t0, zimg, m0, ch); else if (u0.pn == 1) stencil_block<2>(up, t0, zimg, m0, ch);
                        else if (u0.pn == 2) stencil_block<4>(up, t0, zimg, m0, ch); else stencil_block<8>(up, t0, zimg, m0, ch); }
                    __syncthreads();
                }
                pg8::EpiPool E{MIXP, INP(I_PSCALE) + (size_t)l * POOLW};
                pg8::gemm_phase<pg8::EpiPool, PT, false, true>(lds, P, E);
            }
            {
                GEOM(); const gbf* proj = PROJP; gbf* mix = MIXP; const gfl* sinkp = INP(I_SINK) + l * 12;
                for (int u = vcu; u < BATCH * 12 * 16; u += G) {
                    const int qb = u & 15, hh = (u >> 4) % 12, b = u / (16 * 12);
                    const float slope2 = exp2f(-8.0f * (float)(hh + 1) / 12.0f) * LOG2E, sink2 = sinkp[hh] * LOG2E;
                    attn_unit<1>(lds, proj, mix, b, hh, qb, slope2, sink2, 0.f, (const gfl*)nullptr, 1.f);
                }
            }
            {
                GEOM(); const gbf* proj = PROJP; gbf* mix = MIXP; const gfl* subg = INP(I_SUBG) + (size_t)l * 128;
                const gfl* lv = INP(I_LAMBDA) + (size_t)l * 256; const int lane = fresh_tid() & 63;
                const float s1 = wave_sum(lv[lane] * lv[64 + lane]), s2 = wave_sum(lv[128 + lane] * lv[192 + lane]);
                const float lam = __expf(s1) - __expf(s2) + lam_init;
                for (int u = vcu; u < BATCH * 12 * 16; u += G) {
                    const int qb = u & 15, hh = (u >> 4) % 12, b = u / (16 * 12);
                    const float slope2 = exp2f(-8.0f * (float)(hh + 1) / 12.0f) * LOG2E;
                    const GAS unsigned* nm = (const GAS unsigned*)(WSB + WS_CTL) + CW_NMAX + l * 1024 + b * 48 + hh * 4;
                    const float q0 = 1.01f * (__uint_as_float(nm[0]) + __uint_as_float(nm[1])), q1 = 1.01f * (__uint_as_float(nm[2]) + __uint_as_float(nm[3]));
                    const float k0 = 1.01f * (__uint_as_float(nm[BATCH * 48]) + __uint_as_float(nm[BATCH * 48 + 1])), k1 = 1.01f * (__uint_as_float(nm[BATCH * 48 + 2]) + __uint_as_float(nm[BATCH * 48 + 3]));
                    const float bound = 0.125f * LOG2E * sqrtf(fmaxf(q0 * k0, q1 * k1));
                    if (bound <= 60.0f) attn_c_fast(lds, proj, mix, b, hh, qb, slope2, lam, subg, 1.0f - lam_init, k0, k1);
                    else attn_unit<2>(lds, proj, mix, b, hh, qb, slope2, 0.f, lam, subg, 1.0f - lam_init);
                }
            }
        }
        SEAM(pb + 2);
        if (IN(pb + 3)) {
            GEOM();
            typedef pg8::Prob<3, MIX_B, MIX_C, 1536 / 64, 1024 / 64, 1536 / 64> PT; PT P{MIXP, (const gbf*)(WLAYER(l) + W_B), D / 64, D / 64, M / 256, D / 256, G, bx, 0, 1};
            pg8::EpiBranch E{GATESP, MERGP};
            pg8::gemm_phase<pg8::EpiBranch, PT, true, true>(lds, P, E);
        }
        SEAM(pb + 3);
        if (IN(pb + 4)) {
            GEOM();
            typedef pg8::Prob<1, 0, 0, D / 64, 0, 0> PT; PT P{MERGP, (const gbf*)(WLAYER(l) + W_O), D / 64, D / 64, M / 256, D / 256, G, bx, 0, 0};
            pg8::EpiStore E{YB, D};
            pg8::gemm_phase<pg8::EpiStore, PT, true, true>(lds, P, E);
        }
        SEAM(pb + 4);
        if (IN(pb + 5)) { GEOM(); const gfl* modl = MODP + (size_t)l * BATCH * ADA;
            if (l == 0) rownorm_phase<false, true>(INP(I_X), XBP, YB, INP(I_MPOST) + (size_t)l * D, modl + 2 * D, INP(I_FPRE) + (size_t)l * D, modl + 3 * D, modl + 4 * D, HB, bx, G, lds);
            else rownorm_phase<true, true>(XBP, XBP, YB, INP(I_MPOST) + (size_t)l * D, modl + 2 * D, INP(I_FPRE) + (size_t)l * D, modl + 3 * D, modl + 4 * D, HB, bx, G, lds); }
        SEAM(pb + 5);
        if (IN(pb + 6)) {
            GEOM();
            typedef pg8::Prob<1, 0, 0, D / 64, 0, 0> PT; PT P{HB, (const gbf*)(WLAYER(l) + W_F), D / 64, D / 64, M / 256, NF / 256, G, bx, 0, 0};
            pg8::EpiSwiglu E{HIDP};
            pg8::gemm_phase<pg8::EpiSwiglu, PT, true, true>(lds, P, E);
        }
        SEAM(pb + 6);
        if (IN(pb + 7)) {
            GEOM();
            typedef pg8::Prob<1, 0, 0, FF / 64, 0, 0> PT; PT P{HIDP, (const gbf*)(WLAYER(l) + W_D), FF / 64, FF / 64, M / 256, D / 256, G, bx, 0, 0};
            pg8::EpiStore E{YB, D};
            pg8::gemm_phase<pg8::EpiStore, PT, true, true>(lds, P, E);
        }
        SEAM(pb + 7);
        if (IN(pb + 8)) {
            GEOM(); const gfl* modl = MODP + (size_t)l * BATCH * ADA;
            const bool more = (l + 1 < DEPTH); const int ln = more ? l + 1 : l; const gfl* modn = MODP + (size_t)ln * BATCH * ADA;
            if (more) rownorm_phase<true, true>(XBP, XBP, YB, INP(I_FPOST) + (size_t)l * D, modl + 5 * D, INP(I_MPRE) + (size_t)ln * D, modn + 0 * D, modn + 1 * D, HB, bx, G, lds);
            else rownorm_phase<true, false>(XBP, (gfl*)a.out, YB, INP(I_FPOST) + (size_t)l * D, modl + 5 * D, INP(I_MPRE) + (size_t)ln * D, modn + 0 * D, modn + 1 * D, (gbf*)nullptr, bx, G, lds);
        }
        SEAM(pb + 8);
    }
#undef IN
#undef SEAM
}


constexpr int N_PHASES = 2 + 9 * DEPTH;
extern "C" void kernel_launch(void* const* d_in, const int* in_sizes, int n_in, void* d_out, int out_size, void* d_ws, size_t ws_size, hipStream_t stream) {
    static int grid = 0;
    if (grid == 0) {
        if (n_in != 21 || in_sizes[0] != M * D || out_size != M * D || ws_size < WS_END) { fprintf(stderr, "kernel_launch: unexpected shapes (n_in %d, in0 %d, out %d, ws %zu < %zu)\n", n_in, n_in > 0 ? in_sizes[0] : -1, out_size, ws_size, (size_t)WS_END); grid = -1; return; }
        int dev = 0, cus = 0, per_cu = 0;
        if (hipGetDevice(&dev) != hipSuccess || hipDeviceGetAttribute(&cus, hipDeviceAttributeMultiprocessorCount, dev) != hipSuccess) { grid = -1; return; }
        if (hipFuncSetAttribute((const void*)fwd, hipFuncAttributeMaxDynamicSharedMemorySize, LDS_BYTES) != hipSuccess) { fprintf(stderr, "kernel_launch: hipFuncSetAttribute failed\n"); grid = -1; return; }
        if (hipOccupancyMaxActiveBlocksPerMultiprocessor(&per_cu, (const void*)fwd, 512, LDS_BYTES) != hipSuccess || per_cu < 1) fprintf(stderr, "kernel_launch: occupancy query reports %d\n", per_cu);
        (void)hipGetLastError();
        grid = cus;
    }
    if (grid < 0) return;
    if (hipMemsetAsync((char*)d_ws + WS_CTL, 0, CTL_ZERO_BYTES, stream) != hipSuccess) return;
    Args a{};
    for (int i = 0; i < 21; ++i) a.in[i] = (const float*)d_in[i];
    a.out = (float*)d_out; a.ws = (unsigned char*)d_ws;
#if MK_N_LAUNCHES == 1
    a.ph_lo = 0; a.ph_hi = N_PHASES;
    hipLaunchKernelGGL(fwd, dim3(grid), dim3(512), LDS_BYTES, stream, a);
#else
    for (int p = 0; p < N_PHASES; ++p) { a.ph_lo = p; a.ph_hi = p + 1; hipLaunchKernelGGL(fwd, dim3(grid), dim3(512), LDS_BYTES, stream, a); }
#endif
}
```

```cpp
#include <hip/hip_runtime.h>
#include <cstdio>
#include <cstdint>

#ifndef MK_N_LAUNCHES
#define MK_N_LAUNCHES 1
#endif

#define LAS __attribute__((address_space(3)))
#define GAS __attribute__((address_space(1)))
typedef unsigned short bf16_t;
typedef short bf16x8 __attribute__((ext_vector_type(8)));
typedef short s16x4 __attribute__((ext_vector_type(4)));
typedef float f32x4 __attribute__((ext_vector_type(4)));
typedef float f32x2 __attribute__((ext_vector_type(2)));
typedef unsigned u32x4 __attribute__((ext_vector_type(4)));
typedef unsigned u32x2 __attribute__((ext_vector_type(2)));
typedef GAS bf16_t gbf;
typedef GAS float gfl;
typedef GAS unsigned char guc;

constexpr int D = 4096, BATCH = 8, T = 2048, DEPTH = 2, M = BATCH * T;
constexpr int IN_W = 8192, GATE_W = 12288, N1 = IN_W + GATE_W;
constexpr int FF = 11008, NF = 2 * FF;
constexpr int ADA = 6 * D;
constexpr int OFF_QA = 0, OFF_KA = 1536, OFF_VA = 2048, OFF_U = 2560, OFF_QC = 3584, OFF_KC = 5120, OFF_VC = 6656;
constexpr int MIX_B = 1536, MIX_C = 2560;
constexpr int POOLW = 1024;
constexpr float NORM_EPS = 1e-6f, SUBLN_EPS = 1e-5f;
constexpr float LOG2E = 1.4426950408889634f;

constexpr size_t MiB = 1u << 20;
constexpr size_t WS_CTL = 0, CTL_ZERO_BYTES = 1 * MiB;
constexpr size_t WS_MOD = 1 * MiB;
constexpr size_t WS_PWT = 3 * MiB;
constexpr size_t WS_W = 4 * MiB, W_LAYER = 482 * MiB;
constexpr size_t W_1 = 0, W_B = 160 * MiB, W_O = 192 * MiB, W_F = 224 * MiB, W_D = 396 * MiB;
constexpr size_t WS_H = 968 * MiB, WS_MIX = 1096 * MiB, WS_MERG = 1224 * MiB, WS_Y = 1352 * MiB, WS_M32 = 1480 * MiB, WS_Z = 1736 * MiB;
constexpr size_t WS_PROJ = 1768 * MiB, WS_GATES = 2024 * MiB, WS_HID = WS_PROJ, WS_END = 2408 * MiB;
static_assert(WS_W + 2 * W_LAYER == WS_H, "ws map");
static_assert((size_t)M * FF * 2 <= WS_END - WS_HID, "hid overlay");
constexpr int CW_TMO = 0, CW_BAR = 4096, CW_NMAX = 32768;

constexpr int RING_BYTES = 131072;
constexpr int LDSCTL_OFF = RING_BYTES, MISC_OFF = LDSCTL_OFF + 320;
constexpr int LDS_BYTES = 147456;

#define LDS_WAIT() asm volatile("s_waitcnt lgkmcnt(0)" ::: "memory")
#define VM_WAIT() asm volatile("s_waitcnt vmcnt(0)" ::: "memory")

typedef float f32x2_t __attribute__((ext_vector_type(2))); typedef __bf16 bf16x2_t __attribute__((ext_vector_type(2)));
__device__ __forceinline__ unsigned cvt_pk_bf16(float lo, float hi) { f32x2_t v = {lo, hi}; bf16x2_t b = __builtin_convertvector(v, bf16x2_t); return __builtin_bit_cast(unsigned, b); }
__device__ __forceinline__ float bf_lo(unsigned w) { return __uint_as_float(w << 16); }
__device__ __forceinline__ float bf_hi(unsigned w) { return __uint_as_float(w & 0xffff0000u); }
__device__ __forceinline__ float wave_sum(float v) {
#pragma unroll
    for (int o = 1; o < 64; o <<= 1) v += __shfl_xor(v, o);
    return v;
}
__device__ __forceinline__ int opq(int k) { asm volatile("" : "+s"(k)); return k; }
template <class TP> __device__ __forceinline__ TP* opqp(TP* p) { asm volatile("" : "+s"(p)); return p; }
__device__ __forceinline__ int fresh_tid() { int t = threadIdx.x; asm volatile("" : "+v"(t)); return t; }
__device__ __forceinline__ float fast_sigmoid(float x) { return __builtin_amdgcn_rcpf(1.0f + __builtin_amdgcn_exp2f(-x * LOG2E)); }

#define XB_TMO      128
#define XB_XCNT(j)  (256  + 64 * (j))
#define XB_XSUB(j)  (1280 + 64 * (j))
#define XB_XGEN(j)  (2304 + 64 * (j))
#define XB_TOP      3328
#define XB_TOPGEN   3392
#define XCD_BAR_WORDS 3456
#define XB_SPIN_CAP (1u << 18)
__device__ __forceinline__ unsigned xb_ld(unsigned* p)              { return __hip_atomic_load(p, __ATOMIC_RELAXED, __HIP_MEMORY_SCOPE_AGENT); }
__device__ __forceinline__ unsigned xb_add(unsigned* p, unsigned v) { return __hip_atomic_fetch_add(p, v, __ATOMIC_RELAXED, __HIP_MEMORY_SCOPE_AGENT); }
__device__ __forceinline__ unsigned xb_xcc_id() { return (unsigned)__builtin_amdgcn_s_getreg((3 << 11) | 20) & 0xFu; }
#define XB_SPIN(cond, bar) do { unsigned _sp = 0; while (cond) { __builtin_amdgcn_s_sleep(1); \
    if ((++_sp & 255u) == 0u) { if (xb_ld(&(bar)[XB_TMO])) break; if (_sp > XB_SPIN_CAP) { atomicAdd(&(bar)[XB_TMO], 1u); break; } } } } while (0)
struct XcdBarrier { unsigned* bar; unsigned x; volatile LAS unsigned* st; };
__device__ __forceinline__ XcdBarrier xcd_barrier_post(unsigned* bar, volatile LAS unsigned* st) {
    XcdBarrier b; b.bar = bar; b.x = xb_xcc_id(); b.st = st;
    if (threadIdx.x == 0) (void)xb_add(&bar[XB_XCNT(b.x)], 1u);
    return b;
}
__device__ __forceinline__ void xcd_barrier_complete(unsigned* bar, unsigned x, unsigned& nloc, unsigned& nx) {
    const unsigned G = gridDim.x * gridDim.y * gridDim.z;
    unsigned sum, cnt, mine, sp = 0u;
    for (;;) {
        sum = 0u; cnt = 0u; mine = 0u;
#pragma unroll
        for (unsigned j = 0; j < 16; ++j) { const unsigned c = xb_ld(&bar[XB_XCNT(j)]); sum += c; cnt += (c > 0u) ? 1u : 0u; mine = (j == x) ? c : mine; }
        if (sum == G) break;
        __builtin_amdgcn_s_sleep(1);
        if ((++sp & 255u) == 0u) { if (xb_ld(&bar[XB_TMO])) break; if (sp > XB_SPIN_CAP) { atomicAdd(&bar[XB_TMO], 1u); break; } }
    }
    nloc = mine > 0u ? mine : 1u; nx = cnt > 0u ? cnt : 1u;
}
__device__ __forceinline__ void xcd_barrier(const XcdBarrier& b) {
    asm volatile("s_waitcnt vmcnt(0)" ::: "memory");
    __syncthreads();
    if (threadIdx.x == 0) {
        unsigned* bar = b.bar;
        __builtin_amdgcn_s_waitcnt(0);
        unsigned nloc = b.st[0], nx = b.st[1];
        if (nloc == 0u) { xcd_barrier_complete(bar, b.x, nloc, nx); b.st[0] = nloc; b.st[1] = nx; }
        const unsigned old = xb_add(&bar[XB_XSUB(b.x)], 1u);
        const unsigned gen = old / nloc;
        if (old + 1u == (gen + 1u) * nloc) {
            __builtin_amdgcn_fence(__ATOMIC_RELEASE, "agent");
            asm volatile("s_waitcnt vmcnt(0)" ::: "memory");
            const unsigned og = xb_add(&bar[XB_TOP], 1u);
            const unsigned tg = og / nx;
            if (og + 1u == (tg + 1u) * nx) xb_add(&bar[XB_TOPGEN], 1u);
            else XB_SPIN(xb_ld(&bar[XB_TOPGEN]) == tg, bar);
            __builtin_amdgcn_fence(__ATOMIC_ACQUIRE, "agent");
            xb_add(&bar[XB_XGEN(b.x)], 1u);
            asm volatile("s_waitcnt vmcnt(0)" ::: "memory");
        } else {
            XB_SPIN(xb_ld(&bar[XB_XGEN(b.x)]) == gen, bar);
            __builtin_amdgcn_fence(__ATOMIC_ACQUIRE, "agent");
            asm volatile("s_waitcnt vmcnt(0)" ::: "memory");
        }
    }
    __syncthreads();
}

namespace pg8 {
constexpr int BM = 256, BK = 64, HALF = 128, HTB = HALF * BK * 2, STAGE_BYTES = 8 * HTB, NXCD = 8, WGM = 8;
__host__ __device__ __forceinline__ int lds_byte(int r, int c) { const int st = (r >> 4) * 2 + (c >> 5), rr = r & 15, cc = c & 31, ob = rr * 64 + cc * 2; return st * 1024 + (ob ^ (((ob >> 9) & 1) << 5)); }
__host__ __device__ __forceinline__ void stage_rc(int b, int& R, int& C) { const int st = b / 1024, sb = b % 1024, swz = sb ^ (((sb >> 9) & 1) << 5); R = (st >> 1) * 16 + swz / 64; C = (st & 1) * 32 + (swz % 64) / 2; }
__host__ __device__ __forceinline__ int perm32(int rho) { const int n = rho >> 4, i = rho & 15; return 8 * (i >> 2) + 4 * n + (i & 3); }

__host__ __device__ __forceinline__ size_t btile_off(int r, int kt, int c8, int nkt) {
    const int pn = r >> 8, half = (r >> 7) & 1, rl = r & 127, q = rl & 31, rho = (rl & ~31) + 16 * ((q >> 2) & 1) + 4 * (q >> 3) + (q & 3);
    return ((size_t)pn * nkt + kt) * (size_t)(2 * HTB) + (size_t)half * HTB + lds_byte(rho, 8 * c8);
}
__host__ __device__ __forceinline__ size_t atile_off(int r, int k, int nkt) {
    return ((size_t)(r >> 8) * nkt + (k >> 6)) * (size_t)(2 * HTB) + (size_t)((r >> 7) & 1) * HTB + lds_byte(r & 127, k & 56) + (k & 7) * 2;
}
struct Unit { int pm, pn, seg; };
template <int NSEG, int AK1, int AK2, int NT0, int NT1, int NT2>
struct Prob {
    const gbf* A; const gbf* B; int lda, ldb;
    int nM, nN, G, c, apn, bshare;
    __device__ __forceinline__ bool next(int i, Unit& u) const {
        const int nwg = nM * nN; if (c >= nwg) return false;
        const int nr = (nwg - c + G - 1) / G;
        int seg = 0, j = i;
        if constexpr (NSEG > 1) { j = i / NSEG; seg = i - j * NSEG; }
        if (j >= nr) return false;
        int wgid = j * G + c; { const int q = nwg / NXCD, r = nwg % NXCD, xcd = wgid % NXCD, off = wgid / NXCD; wgid = (xcd < r ? xcd * (q + 1) : r * (q + 1) + (xcd - r) * q) + off; }
        const int nig = WGM * nN, gid = wgid / nig, fm = gid * WGM, gsz = (nM - fm) < WGM ? (nM - fm) : WGM;
        u.pm = fm + ((wgid % nig) % gsz); u.pn = (wgid % nig) / gsz; u.seg = seg; return true;
    }
    __device__ __forceinline__ int nt(const Unit& u) const { if constexpr (NSEG == 1) return NT0; else return u.seg == 0 ? NT0 : (u.seg == 1 ? NT1 : NT2); }
    __device__ __forceinline__ int ak(const Unit& u) const { if constexpr (NSEG == 1) return 0; else return u.seg == 0 ? 0 : (u.seg == 1 ? AK1 : AK2); }
    __device__ __forceinline__ const GAS char* a_ptr(const Unit& u) const { return (const GAS char*)A + ((size_t)u.pm * lda + (ak(u) + u.pn * apn) / BK) * (size_t)(2 * HTB); }
    __device__ __forceinline__ const GAS char* b_ptr(const Unit& u) const { return (const GAS char*)B + ((size_t)u.pn * ldb + (bshare ? ak(u) / BK : 0)) * (size_t)(2 * HTB); }
};

template <class Epi, class ProbT, bool ALIGN_EPI, bool SP2>
__device__ __forceinline__ void gemm_phase(LAS unsigned char* lds, const ProbT& P, const Epi& E) {
    const int tid = fresh_tid(), wid = __builtin_amdgcn_readfirstlane(tid >> 6), lane = tid & 63, wr = wid >> 2, wc = wid & 3, fr = lane & 15, fq = lane >> 4;
    unsigned voffA[2], voffB[2];
#pragma unroll
    for (int i = 0; i < 2; ++i) { int R, C; stage_rc(tid * 16 + i * 8192, R, C); const int Rb = (R & ~31) + perm32(R & 31);
        voffA[i] = (unsigned)(tid * 16 + i * 8192); voffB[i] = voffA[i]; (void)Rb; (void)R; (void)C; }
    const size_t kstepB = (size_t)(2 * HTB), kstep = kstepB;
    const size_t hstepA = (size_t)HTB, hstepB = (size_t)HTB;
    const unsigned ldsw = (unsigned)wid * 1024u;
    const int aoff = lds_byte(wr * 64 + fr, fq * 8), boff = lds_byte(wc * 32 + fr, fq * 8);
#define PG8_SA(b, h) (((b) * 2 + (h)) * HTB)
#define PG8_SB(b, h) ((4 + (b) * 2 + (h)) * HTB)
#define PG8_STAGE(bufoff, gbase, voff) do { _Pragma("unroll") for (int _i = 0; _i < 2; ++_i) \
        __builtin_amdgcn_global_load_lds((const GAS unsigned*)((const GAS char*)(gbase) + (voff)[_i]), (LAS unsigned*)(lds + (bufoff) + ldsw + _i * 8192), 16, 0, 0); } while (0)
#define PG8_LDA(dst, b, h) do { _Pragma("unroll") for (int m = 0; m < 4; ++m) _Pragma("unroll") for (int k = 0; k < 2; ++k) dst[m][k] = *(const LAS bf16x8*)(lds + PG8_SA(b, h) + aoff + m * 2048 + k * 1024); } while (0)
#define PG8_LDB(dst, b, h) do { _Pragma("unroll") for (int n = 0; n < 2; ++n) _Pragma("unroll") for (int k = 0; k < 2; ++k) dst[n][k] = *(const LAS bf16x8*)(lds + PG8_SB(b, h) + boff + n * 2048 + k * 1024); } while (0)
#define PG8_MMA(ai, bj, At, Bt) do { __builtin_amdgcn_s_setprio(1); _Pragma("unroll") for (int m = 0; m < 4; ++m) _Pragma("unroll") for (int n = 0; n < 2; ++n) _Pragma("unroll") for (int k = 0; k < 2; ++k) \
        acc[ai][bj][m][n] = __builtin_amdgcn_mfma_f32_16x16x32_bf16(Bt[n][k], At[m][k], acc[ai][bj][m][n], 0, 0, 0); __builtin_amdgcn_s_setprio(0); } while (0)
#define PG8_WAIT_V(n) asm volatile("s_waitcnt vmcnt(" #n ")" ::: "memory")
#define PG8_WAIT_L(n) asm volatile("s_waitcnt lgkmcnt(" #n ")" ::: "memory")
#define PG8_BAR __builtin_amdgcn_s_barrier()
#define PG8_SCHED __builtin_amdgcn_sched_barrier(0)
    Unit cur, nxt; int ui = 0;
    if (!P.next(0, cur)) return;
    f32x4 acc[2][2][4][2];
#pragma unroll
    for (int a = 0; a < 2; ++a)
#pragma unroll
        for (int b = 0; b < 2; ++b)
#pragma unroll
            for (int m = 0; m < 4; ++m)
#pragma unroll
                for (int n = 0; n < 2; ++n) acc[a][b][m][n] = (f32x4){0.f, 0.f, 0.f, 0.f};
    bf16x8 At[4][2], B0[2][2], B1[2][2];
    const GAS char* cA = P.a_ptr(cur); const GAS char* cB = P.b_ptr(cur); int nt = P.nt(cur);
    if constexpr (SP2) {
        PG8_STAGE(PG8_SB(0, 0), cB, voffB); PG8_STAGE(PG8_SB(0, 1), cB + hstepB, voffB); PG8_STAGE(PG8_SA(0, 0), cA, voffA); PG8_STAGE(PG8_SA(0, 1), cA + hstepA, voffA);
        if (wr == 1) PG8_BAR;
        PG8_WAIT_V(2); PG8_BAR;
        PG8_STAGE(PG8_SB(1, 0), cB + kstepB, voffB); PG8_STAGE(PG8_SA(1, 0), cA + kstep, voffA); PG8_STAGE(PG8_SB(1, 1), cB + hstepB + kstepB, voffB);
        PG8_WAIT_V(6); PG8_BAR;
    } else {
        PG8_STAGE(PG8_SB(0, 0), cB, voffB); PG8_STAGE(PG8_SA(0, 0), cA, voffA); PG8_STAGE(PG8_SB(0, 1), cB + hstepB, voffB); PG8_STAGE(PG8_SA(0, 1), cA + hstepA, voffA);
        if (wr == 1) PG8_BAR;
        PG8_WAIT_V(4); PG8_BAR;
        PG8_STAGE(PG8_SB(1, 0), cB + kstepB, voffB); PG8_STAGE(PG8_SA(1, 0), cA + kstep, voffA); PG8_STAGE(PG8_SB(1, 1), cB + hstepB + kstepB, voffB);
        PG8_WAIT_V(6); PG8_BAR;
    }
    for (;;) {
        const bool has_next = P.next(ui + 1, nxt);
        const GAS char* nA = has_next ? P.a_ptr(nxt) : cA; const GAS char* nB = has_next ? P.b_ptr(nxt) : cB;
#pragma nounroll
        for (int t = 0; t < nt; t += 2) {
            const bool last = (t == nt - 2);
            const GAS char* a1 = cA + (size_t)(t + 1) * kstep;
            const GAS char* a2 = last ? nA : cA + (size_t)(t + 2) * kstep; const GAS char* b2 = last ? nB : cB + (size_t)(t + 2) * kstepB;
            const GAS char* a3 = a2 + kstep; const GAS char* b3 = b2 + kstepB;
            if constexpr (SP2) {
            PG8_LDB(B0, 0, 0); PG8_LDB(B1, 0, 1); PG8_SCHED; PG8_LDA(At, 0, 0); PG8_STAGE(PG8_SA(1, 1), a1 + hstepA, voffA);
            PG8_WAIT_V(8); PG8_WAIT_L(0); PG8_BAR; PG8_MMA(0, 0, At, B0); PG8_MMA(0, 1, At, B1); PG8_BAR; PG8_SCHED;
            PG8_LDA(At, 0, 1); PG8_STAGE(PG8_SB(0, 0), b2, voffB); PG8_STAGE(PG8_SB(0, 1), b2 + hstepB, voffB); PG8_STAGE(PG8_SA(0, 0), a2, voffA);
            PG8_WAIT_V(8); PG8_WAIT_L(0); PG8_BAR; PG8_MMA(1, 0, At, B0); PG8_MMA(1, 1, At, B1); PG8_BAR; PG8_SCHED;
            PG8_LDB(B0, 1, 0); PG8_LDB(B1, 1, 1); PG8_SCHED; PG8_LDA(At, 1, 0); PG8_STAGE(PG8_SA(0, 1), a2 + hstepA, voffA);
            PG8_WAIT_V(8); PG8_WAIT_L(0); PG8_BAR; PG8_MMA(0, 0, At, B0); PG8_MMA(0, 1, At, B1); PG8_BAR; PG8_SCHED;
            PG8_LDA(At, 1, 1); PG8_STAGE(PG8_SB(1, 0), b3, voffB); PG8_STAGE(PG8_SB(1, 1), b3 + hstepB, voffB); PG8_STAGE(PG8_SA(1, 0), a3, voffA);
            PG8_WAIT_V(8); PG8_WAIT_L(0); PG8_BAR; PG8_MMA(1, 0, At, B0); PG8_MMA(1, 1, At, B1); PG8_BAR; PG8_SCHED;
            } else {
            PG8_LDB(B0, 0, 0); PG8_SCHED; PG8_LDA(At, 0, 0); PG8_STAGE(PG8_SA(1, 1), a1 + hstepA, voffA);
            PG8_WAIT_L(8); PG8_BAR; PG8_WAIT_L(0); PG8_MMA(0, 0, At, B0); PG8_BAR; PG8_SCHED;
            PG8_LDB(B1, 0, 1); PG8_STAGE(PG8_SB(0, 0), b2, voffB);
            PG8_BAR; PG8_WAIT_L(0); PG8_MMA(0, 1, At, B1); PG8_BAR;
            PG8_LDA(At, 0, 1); PG8_STAGE(PG8_SA(0, 0), a2, voffA);
            PG8_BAR; PG8_WAIT_L(0); PG8_MMA(1, 0, At, B0); PG8_BAR; PG8_SCHED;
            PG8_STAGE(PG8_SB(0, 1), b2 + hstepB, voffB);
            PG8_WAIT_V(6); PG8_BAR; PG8_MMA(1, 1, At, B1); PG8_BAR;
            PG8_LDB(B0, 1, 0); PG8_SCHED; PG8_LDA(At, 1, 0); PG8_STAGE(PG8_SA(0, 1), a2 + hstepA, voffA);
            PG8_WAIT_L(8); PG8_BAR; PG8_WAIT_L(0); PG8_MMA(0, 0, At, B0); PG8_BAR; PG8_SCHED;
            PG8_LDB(B1, 1, 1); PG8_STAGE(PG8_SB(1, 0), b3, voffB);
            PG8_BAR; PG8_WAIT_L(0); PG8_MMA(0, 1, At, B1); PG8_BAR;
            PG8_LDA(At, 1, 1); PG8_STAGE(PG8_SA(1, 0), a3, voffA);
            PG8_BAR; PG8_WAIT_L(0); PG8_MMA(1, 0, At, B0); PG8_BAR; PG8_SCHED;
            PG8_STAGE(PG8_SB(1, 1), b3 + hstepB, voffB);
            PG8_WAIT_V(6); PG8_BAR; PG8_MMA(1, 1, At, B1); PG8_BAR;
            }
        }
        if constexpr (ALIGN_EPI) { if (wr == 0) PG8_BAR; }
        E(acc, cur, wr, wc, fr, fq);
        if (!has_next) break;
        if (!E.keep(cur)) {
#pragma unroll
        for (int a = 0; a < 2; ++a)
#pragma unroll
            for (int b = 0; b < 2; ++b)
#pragma unroll
                for (int m = 0; m < 4; ++m)
#pragma unroll
                    for (int n = 0; n < 2; ++n) acc[a][b][m][n] = (f32x4){0.f, 0.f, 0.f, 0.f};
        }
        cur = nxt; cA = nA; cB = nB; nt = P.nt(cur); ++ui;
        if constexpr (ALIGN_EPI) { if (wr == 1) PG8_BAR; }
    }
    PG8_WAIT_V(0);
    if constexpr (!ALIGN_EPI) { if (wr == 0) PG8_BAR; }
    PG8_BAR;
#undef PG8_SA
#undef PG8_SB
#undef PG8_STAGE
#undef PG8_LDA
#undef PG8_LDB
#undef PG8_MMA
#undef PG8_WAIT_V
#undef PG8_WAIT_L
#undef PG8_BAR
#undef PG8_SCHED
}

__device__ __forceinline__ u32x4 pack8(const f32x4 v0, const f32x4 v1) { u32x4 w; w.x = cvt_pk_bf16(v0[0], v0[1]); w.y = cvt_pk_bf16(v0[2], v0[3]); w.z = cvt_pk_bf16(v1[0], v1[1]); w.w = cvt_pk_bf16(v1[2], v1[3]); return w; }

struct EpiInGate {
    __device__ __forceinline__ bool keep(const Unit&) const { return false; }
    gbf* proj; gbf* gates; const gfl* bgate; GAS unsigned* nmax;
    __device__ __forceinline__ void operator()(const f32x4 (&acc)[2][2][4][2], const Unit& u, int wr, int wc, int fr, int fq) const {
        const int row0 = u.pm * BM + wr * 64 + fr;
        if (u.pn < IN_W / BM) {
            const int col0 = u.pn * BM + wc * 32 + 8 * fq;
            if (u.pn >= OFF_QC / BM && u.pn < OFF_VC / BM) {
#pragma unroll
                for (int bj = 0; bj < 2; ++bj) {
                    float mx = 0.f;
#pragma unroll
                    for (int ai = 0; ai < 2; ++ai)
#pragma unroll
                        for (int m = 0; m < 4; ++m) { const f32x4 a = acc[ai][bj][m][0], e = acc[ai][bj][m][1];
                            float ss = (a[0] * a[0] + a[1] * a[1]) + (a[2] * a[2] + a[3] * a[3]) + (e[0] * e[0] + e[1] * e[1]) + (e[2] * e[2] + e[3] * e[3]);
                            ss += __shfl_xor(ss, 16); ss += __shfl_xor(ss, 32); mx = fmaxf(mx, ss); }
                    mx = fmaxf(mx, __shfl_xor(mx, 1)); mx = fmaxf(mx, __shfl_xor(mx, 2)); mx = fmaxf(mx, __shfl_xor(mx, 4)); mx = fmaxf(mx, __shfl_xor(mx, 8));
                    const int cq = u.pn * BM + bj * HALF + wc * 32 - OFF_QC;
                    const int qk = cq >= (OFF_KC - OFF_QC) ? 1 : 0, g32 = (cq - qk * (OFF_KC - OFF_QC)) >> 5, bb = (u.pm * BM) / T;
                    if (fr == 0 && fq == 0) __hip_atomic_fetch_max(nmax + (qk * BATCH + bb) * 48 + g32, __float_as_uint(mx), __ATOMIC_RELAXED, __HIP_MEMORY_SCOPE_AGENT);
                }
            }
#pragma unroll
            for (int ai = 0; ai < 2; ++ai)
#pragma unroll
                for (int m = 0; m < 4; ++m) { gbf* rowp = proj + (size_t)(row0 + ai * HALF + m * 16) * IN_W + col0;
#pragma unroll
                    for (int bj = 0; bj < 2; ++bj) *(GAS u32x4*)(rowp + bj * HALF) = pack8(acc[ai][bj][m][0], acc[ai][bj][m][1]); }
        } else {
            const int col0 = (u.pn - IN_W / BM) * BM + wc * 32 + 8 * fq;
            f32x4 bv[2][2];
#pragma unroll
            for (int bj = 0; bj < 2; ++bj)
#pragma unroll
                for (int n = 0; n < 2; ++n) bv[bj][n] = *(const GAS f32x4*)(bgate + col0 + bj * HALF + 4 * n);
#pragma unroll
            for (int ai = 0; ai < 2; ++ai)
#pragma unroll
                for (int m = 0; m < 4; ++m) {
#pragma unroll
                    for (int bj = 0; bj < 2; ++bj) { f32x4 v0 = acc[ai][bj][m][0] + bv[bj][0], v1 = acc[ai][bj][m][1] + bv[bj][1];
#pragma unroll
                        for (int j = 0; j < 4; ++j) { v0[j] = fast_sigmoid(v0[j]); v1[j] = fast_sigmoid(v1[j]); }
                        *(GAS u32x4*)((guc*)gates + atile_off(row0 + ai * HALF + m * 16, col0 + bj * HALF, GATE_W / BK)) = pack8(v0, v1); } }
        }
    }
};
struct EpiPool {
    __device__ __forceinline__ bool keep(const Unit&) const { return false; }
    gbf* mix; const gfl* pscale;
    __device__ __forceinline__ void operator()(const f32x4 (&acc)[2][2][4][2], const Unit& u, int wr, int wc, int fr, int fq) const {
        const int row0 = u.pm * BM + wr * 64 + fr, col0 = u.pn * BM + wc * 32 + 8 * fq;
        f32x4 sv[2][2];
#pragma unroll
        for (int bj = 0; bj < 2; ++bj)
#pragma unroll
            for (int n = 0; n < 2; ++n) sv[bj][n] = *(const GAS f32x4*)(pscale + col0 + bj * HALF + 4 * n);
#pragma unroll
        for (int ai = 0; ai < 2; ++ai)
#pragma unroll
            for (int m = 0; m < 4; ++m) {
#pragma unroll
                for (int bj = 0; bj < 2; ++bj) *(GAS u32x4*)((guc*)mix + atile_off(row0 + ai * HALF + m * 16, MIX_B + col0 + bj * HALF, D / BK)) = pack8(acc[ai][bj][m][0] * sv[bj][0], acc[ai][bj][m][1] * sv[bj][1]); }
    }
};
struct EpiBranch {
    const gbf* gates; gbf* merged;
    __device__ __forceinline__ bool keep(const Unit& u) const { return u.seg < 2; }
    __device__ __forceinline__ static void unpack(const u32x4 w, f32x4& lo, f32x4& hi) { lo = (f32x4){bf_lo(w.x), bf_hi(w.x), bf_lo(w.y), bf_hi(w.y)}; hi = (f32x4){bf_lo(w.z), bf_hi(w.z), bf_lo(w.w), bf_hi(w.w)}; }
    __device__ __forceinline__ void operator()(f32x4 (&acc)[2][2][4][2], const Unit& u, int wr, int wc, int fr, int fq) const {
        const int row0 = u.pm * BM + wr * 64 + fr, col0 = u.pn * BM + wc * 32 + 8 * fq;
        const guc* gimg = (const guc*)gates; const int gcol = u.seg * D + col0;
        if (u.seg < 2) {
#pragma unroll
            for (int ai = 0; ai < 2; ++ai) {
                u32x4 gw[4][2], hw[4][2];
#pragma unroll
                for (int m = 0; m < 4; ++m)
#pragma unroll
                    for (int bj = 0; bj < 2; ++bj) { const guc* gp = gimg + atile_off(row0 + ai * HALF + m * 16, gcol + bj * HALF, GATE_W / BK); gw[m][bj] = *(const GAS u32x4*)gp; hw[m][bj] = *(const GAS u32x4*)(gp + (size_t)(D / BK) * (2 * HTB)); }
#pragma unroll
                for (int m = 0; m < 4; ++m)
#pragma unroll
                    for (int bj = 0; bj < 2; ++bj) { f32x4 g0, g1, h0, h1; unpack(gw[m][bj], g0, g1); unpack(hw[m][bj], h0, h1);
#pragma unroll
                        for (int j = 0; j < 4; ++j) { g0[j] = fmaxf(g0[j], 1e-30f) * __builtin_amdgcn_rcpf(fmaxf(h0[j], 1e-30f)); g1[j] = fmaxf(g1[j], 1e-30f) * __builtin_amdgcn_rcpf(fmaxf(h1[j], 1e-30f)); }
                        acc[ai][bj][m][0] *= g0; acc[ai][bj][m][1] *= g1; }
            }
        } else {
#pragma unroll
            for (int ai = 0; ai < 2; ++ai) {
                u32x4 gw[4][2];
#pragma unroll
                for (int m = 0; m < 4; ++m)
#pragma unroll
                    for (int bj = 0; bj < 2; ++bj) gw[m][bj] = *(const GAS u32x4*)(gimg + atile_off(row0 + ai * HALF + m * 16, gcol + bj * HALF, GATE_W / BK));
#pragma unroll
                for (int m = 0; m < 4; ++m)
#pragma unroll
                    for (int bj = 0; bj < 2; ++bj) { f32x4 g0, g1; unpack(gw[m][bj], g0, g1);
#pragma unroll
                        for (int j = 0; j < 4; ++j) { g0[j] = fmaxf(g0[j], 1e-30f); g1[j] = fmaxf(g1[j], 1e-30f); }
                        *(GAS u32x4*)((guc*)merged + atile_off(row0 + ai * HALF + m * 16, col0 + bj * HALF, D / BK)) = pack8(acc[ai][bj][m][0] * g0, acc[ai][bj][m][1] * g1); }
            }
        }
    }
};
struct EpiStore {
    __device__ __forceinline__ bool keep(const Unit&) const { return false; }
    gbf* O; int ldc;
    __device__ __forceinline__ void operator()(const f32x4 (&acc)[2][2][4][2], const Unit& u, int wr, int wc, int fr, int fq) const {
        const int row0 = u.pm * BM + wr * 64 + fr, col0 = u.pn * BM + wc * 32 + 8 * fq;
#pragma unroll
        for (int ai = 0; ai < 2; ++ai)
#pragma unroll
            for (int m = 0; m < 4; ++m) {
#pragma unroll
                for (int bj = 0; bj < 2; ++bj) *(GAS u32x4*)((guc*)O + atile_off(row0 + ai * HALF + m * 16, col0 + bj * HALF, ldc / BK)) = pack8(acc[ai][bj][m][0], acc[ai][bj][m][1]); }
    }
};
struct EpiSwiglu {
    __device__ __forceinline__ bool keep(const Unit&) const { return false; }
    gbf* hid;
    __device__ __forceinline__ void operator()(const f32x4 (&acc)[2][2][4][2], const Unit& u, int wr, int wc, int fr, int fq) const {
        const int row0 = u.pm * BM + wr * 64 + fr, col0 = u.pn * HALF + wc * 32 + 8 * fq;
#pragma unroll
        for (int ai = 0; ai < 2; ++ai)
#pragma unroll
            for (int m = 0; m < 4; ++m) { f32x4 v0, v1;
#pragma unroll
                for (int j = 0; j < 4; ++j) { const float a0 = acc[ai][0][m][0][j], a1 = acc[ai][0][m][1][j];
                    v0[j] = a0 * fast_sigmoid(a0) * acc[ai][1][m][0][j]; v1[j] = a1 * fast_sigmoid(a1) * acc[ai][1][m][1][j]; }
                *(GAS u32x4*)((guc*)hid + atile_off(row0 + ai * HALF + m * 16, col0, FF / BK)) = pack8(v0, v1); }
    }
};
}

constexpr int AT_PITCH = 288, AT_TILE = 64 * AT_PITCH, AT_BUF = 2 * AT_TILE;
template <int NS>
__device__ __forceinline__ void attn_unit(LAS unsigned char* lds, const gbf* __restrict__ proj, gbf* __restrict__ mix, int b, int h, int qb,
                                          float slope2, float sink2, float lam, const gfl* __restrict__ subg, float outscale) {
    const int tid = fresh_tid(), wave = __builtin_amdgcn_readfirstlane(tid >> 6), lane = tid & 63, g = lane >> 4, i16 = lane & 15;
    const int qcol = (NS == 1 ? OFF_QA : OFF_QC) + h * 128;
    const int kcol = (NS == 1 ? OFF_KA + (h / 3) * 128 : OFF_KC + h * 128);
    const int vcol = (NS == 1 ? OFF_VA + (h / 3) * 128 : OFF_VC + h * 128);
    const int tq = qb * 128 + wave * 16 + i16;
    const gbf* rowbase = proj + (size_t)b * T * IN_W;
    bf16x8 qf[4];
#pragma unroll
    for (int kk = 0; kk < 4; ++kk) qf[kk] = *(const GAS bf16x8*)(rowbase + (size_t)tq * IN_W + qcol + kk * 32 + 8 * g);
    int jlo, jhi, kbase;
    if (NS == 1) { kbase = qb * 128 - 128; jlo = (qb == 0) ? 2 : 0; jhi = (qb == T / 128 - 1) ? 4 : 6; } else { kbase = 0; jlo = 0; jhi = T / 64; }
    const float c1 = (NS == 1 ? 0.08838834764831845f : 0.125f) * LOG2E;
    f32x4 O[NS][8]; float mrun[NS], lrun[NS];
#pragma unroll
    for (int s = 0; s < NS; ++s) { mrun[s] = (NS == 1) ? sink2 : -1e30f; lrun[s] = (NS == 1 && g == 0) ? 1.0f : 0.0f;
#pragma unroll
        for (int dt = 0; dt < 8; ++dt) O[s][dt] = (f32x4){0.f, 0.f, 0.f, 0.f}; }
    const int skey = tid >> 4, sch = tid & 15;
    u32x4 kreg[2], vreg[2];
    auto gload = [&](int j) { const int kp0 = kbase + 64 * j;
#pragma unroll
        for (int i = 0; i < 2; ++i) { const gbf* rp = rowbase + (size_t)(kp0 + skey + 32 * i) * IN_W + sch * 8;
            kreg[i] = *(const GAS u32x4*)(rp + kcol); vreg[i] = *(const GAS u32x4*)(rp + vcol); } };
    auto lstore = [&](int buf) { LAS unsigned char* bp = lds + buf * AT_BUF + (skey) * AT_PITCH + sch * 16;
#pragma unroll
        for (int i = 0; i < 2; ++i) { *(LAS u32x4*)(bp + i * 32 * AT_PITCH) = kreg[i]; *(LAS u32x4*)(bp + AT_TILE + i * 32 * AT_PITCH) = vreg[i]; } };
    gload(jlo);
    __syncthreads();
    lstore(0);
    __syncthreads();
    const int koff = i16 * AT_PITCH + 16 * g;
    const int voff = AT_TILE + (4 * g + (i16 >> 2)) * AT_PITCH + (i16 & 3) * 8;
    float slo[4][4];
#pragma unroll
    for (int kt = 0; kt < 4; ++kt)
#pragma unroll
        for (int r = 0; r < 4; ++r) slo[kt][r] = slope2 * (float)(kt * 16 + 4 * g + r);
    const int tqw = qb * 128 + wave * 16;
    constexpr float THR = 8.0f;
    for (int j = jlo; j < jhi; ++j) {
        const int buf = (j - jlo) & 1;
        if (j + 1 < jhi) gload(j + 1);
        LAS unsigned char* bp = lds + buf * AT_BUF;
        const int kp0 = kbase + 64 * j;
        f32x4 st[NS][4];
#pragma unroll
        for (int s = 0; s < NS; ++s)
#pragma unroll
            for (int kt = 0; kt < 4; ++kt) { st[s][kt] = (f32x4){0.f, 0.f, 0.f, 0.f};
#pragma unroll
                for (int kk = 0; kk < 4 / NS; ++kk) { const int kq = s * (4 / NS) + kk;
                    const bf16x8 kf = *(const LAS bf16x8*)(bp + koff + kt * 16 * AT_PITCH + kq * 64);
                    st[s][kt] = __builtin_amdgcn_mfma_f32_16x16x32_bf16(kf, qf[kq], st[s][kt], 0, 0, 0); } }
        f32x4 B[4];
        const float d0 = (float)(tq - kp0);
        if (kp0 + 63 <= tqw) {
            const float c0 = -slope2 * d0;
#pragma unroll
            for (int kt = 0; kt < 4; ++kt)
#pragma unroll
                for (int r = 0; r < 4; ++r) B[kt][r] = c0 + slo[kt][r];
        } else if (kp0 >= tqw + 15) {
            const float c0 = slope2 * d0;
#pragma unroll
            for (int kt = 0; kt < 4; ++kt)
#pragma unroll
                for (int r = 0; r < 4; ++r) B[kt][r] = c0 - slo[kt][r];
        } else {
#pragma unroll
            for (int kt = 0; kt < 4; ++kt)
#pragma unroll
                for (int r = 0; r < 4; ++r) { const float ad = fabsf(d0 - (float)(kt * 16 + 4 * g + r)); float bb = -slope2 * ad; if (NS == 1) bb = (ad <= 128.0f) ? bb : -1e30f; B[kt][r] = bb; }
        }
        if (NS == 1 && (kp0 + 63 <= tqw || kp0 >= tqw + 15)) {
#pragma unroll
            for (int kt = 0; kt < 4; ++kt)
#pragma unroll
                for (int r = 0; r < 4; ++r) { const float ad = fabsf(d0 - (float)(kt * 16 + 4 * g + r)); B[kt][r] = (ad <= 128.0f) ? B[kt][r] : -1e30f; }
        }
        bf16x8 pf[NS][2];
#pragma unroll
        for (int s = 0; s < NS; ++s) {
            float tmax = -1e30f;
#pragma unroll
            for (int kt = 0; kt < 4; ++kt) {
#pragma unroll
                for (int r = 0; r < 4; ++r) st[s][kt][r] = fmaf(st[s][kt][r], c1, B[kt][r]);
                tmax = fmaxf(tmax, fmaxf(fmaxf(st[s][kt][0], st[s][kt][1]), fmaxf(st[s][kt][2], st[s][kt][3]))); }
            if (__any(tmax > mrun[s] + THR)) {
                tmax = fmaxf(tmax, __shfl_xor(tmax, 16)); tmax = fmaxf(tmax, __shfl_xor(tmax, 32));
                const float mnew = fmaxf(mrun[s], tmax), alpha = __builtin_amdgcn_exp2f(mrun[s] - mnew); mrun[s] = mnew;
                lrun[s] *= alpha;
#pragma unroll
                for (int dt = 0; dt < 8; ++dt) O[s][dt] *= alpha;
            }
            const float mcur = mrun[s];
            float psum = 0.f;
#pragma unroll
            for (int kt = 0; kt < 4; ++kt)
#pragma unroll
                for (int r = 0; r < 4; ++r) { const float p = __builtin_amdgcn_exp2f(st[s][kt][r] - mcur); st[s][kt][r] = p; psum += p; }
            lrun[s] += psum;
#pragma unroll
            for (int k2 = 0; k2 < 2; ++k2) { u32x4 w; w.x = cvt_pk_bf16(st[s][2 * k2][0], st[s][2 * k2][1]); w.y = cvt_pk_bf16(st[s][2 * k2][2], st[s][2 * k2][3]);
                w.z = cvt_pk_bf16(st[s][2 * k2 + 1][0], st[s][2 * k2 + 1][1]); w.w = cvt_pk_bf16(st[s][2 * k2 + 1][2], st[s][2 * k2 + 1][3]); pf[s][k2] = __builtin_bit_cast(bf16x8, w); }
        }
#pragma unroll
        for (int dt = 0; dt < 8; ++dt)
#pragma unroll
            for (int k2 = 0; k2 < 2; ++k2) {
                const s16x4 lo = __builtin_bit_cast(s16x4, __builtin_amdgcn_ds_read_tr16_b64_v4i16((LAS s16x4*)(bp + voff + (k2 * 32) * AT_PITCH + dt * 32)));
                const s16x4 hi = __builtin_bit_cast(s16x4, __builtin_amdgcn_ds_read_tr16_b64_v4i16((LAS s16x4*)(bp + voff + (k2 * 32 + 16) * AT_PITCH + dt * 32)));
                const bf16x8 vf = {lo[0], lo[1], lo[2], lo[3], hi[0], hi[1], hi[2], hi[3]};
#pragma unroll
                for (int s = 0; s < NS; ++s) O[s][dt] = __builtin_amdgcn_mfma_f32_16x16x32_bf16(vf, pf[s][k2], O[s][dt], 0, 0, 0);
            }
        if (j + 1 < jhi) lstore(buf ^ 1);
        __syncthreads();
    }
    float inv[NS];
#pragma unroll
    for (int s = 0; s < NS; ++s) { float l = lrun[s]; l += __shfl_xor(l, 16); l += __shfl_xor(l, 32); inv[s] = 1.0f / l; }
    const int orow_r = b * T + tq, ocol = (NS == 1 ? 0 : MIX_C) + h * 128 + 4 * g;
    if (NS == 1) {
#pragma unroll
        for (int dt = 0; dt < 8; ++dt) { const f32x4 o = O[0][dt] * inv[0]; u32x2 w; w.x = cvt_pk_bf16(o[0], o[1]); w.y = cvt_pk_bf16(o[2], o[3]); *(GAS u32x2*)((guc*)mix + pg8::atile_off(orow_r, ocol + 16 * dt, D / 64)) = w; }
    } else {
        float ss = 0.f;
#pragma unroll
        for (int dt = 0; dt < 8; ++dt) { O[0][dt] = O[0][dt] * inv[0] - (O[NS - 1][dt] * inv[NS - 1]) * lam; const f32x4 o = O[0][dt]; ss += (o[0] * o[0] + o[1] * o[1]) + (o[2] * o[2] + o[3] * o[3]); }
        ss += __shfl_xor(ss, 16); ss += __shfl_xor(ss, 32);
        const float rs = rsqrtf(ss * (1.0f / 128.0f) + SUBLN_EPS) * outscale;
#pragma unroll
        for (int dt = 0; dt < 8; ++dt) { const f32x4 gv = *(const GAS f32x4*)(subg + 16 * dt + 4 * g); const f32x4 o = O[0][dt] * rs * gv;
            u32x2 w; w.x = cvt_pk_bf16(o[0], o[1]); w.y = cvt_pk_bf16(o[2], o[3]); *(GAS u32x2*)((guc*)mix + pg8::atile_off(orow_r, ocol + 16 * dt, D / 64)) = w; }
    }
}


constexpr int NTC = T / 64;
__device__ __forceinline__ void attn_c_fast(LAS unsigned char* lds, const gbf* __restrict__ proj, gbf* __restrict__ mix, int b, int h, int qb,
                                            float slope2, float lam, const gfl* __restrict__ subg, float outscale, float kmax2_0, float kmax2_1) {
    const int tid = fresh_tid(), wave = __builtin_amdgcn_readfirstlane(tid >> 6), lane = tid & 63, g = lane >> 4, i16 = lane & 15;
    const int qcol = OFF_QC + h * 128, kcol = OFF_KC + h * 128, vcol = OFF_VC + h * 128;
    const int tq = qb * 128 + wave * 16 + i16, tqw = qb * 128 + wave * 16;
    const gbf* rowbase = proj + (size_t)b * T * IN_W;
    const float c1 = 0.125f * LOG2E;
    bf16x8 qf[4];
#pragma unroll
    for (int kk = 0; kk < 4; ++kk) qf[kk] = *(const GAS bf16x8*)(rowbase + (size_t)tq * IN_W + qcol + kk * 32 + 8 * g);
    float mref[2];
#pragma unroll
    for (int s = 0; s < 2; ++s) { float ss = 0.f;
#pragma unroll
        for (int kk = 0; kk < 2; ++kk)
#pragma unroll
            for (int e = 0; e < 8; ++e) { const float v = __uint_as_float(((unsigned)(unsigned short)qf[2 * s + kk][e]) << 16); ss += v * v; }
        ss += __shfl_xor(ss, 16); ss += __shfl_xor(ss, 32);
        mref[s] = c1 * sqrtf(ss * (s == 0 ? kmax2_0 : kmax2_1)) + 1.0f; }
    float slo[4][4];
#pragma unroll
    for (int kt = 0; kt < 4; ++kt)
#pragma unroll
        for (int r = 0; r < 4; ++r) slo[kt][r] = (float)(kt * 16 + 4 * g + r);
    f32x4 O[2][8]; float lrun[2] = {0.f, 0.f};
#pragma unroll
    for (int s = 0; s < 2; ++s)
#pragma unroll
        for (int dt = 0; dt < 8; ++dt) O[s][dt] = (f32x4){0.f, 0.f, 0.f, 0.f};
    const int skey = tid >> 4, sch = tid & 15;
    u32x4 kreg[2], vreg[2];
    const gbf* sbase = rowbase + (size_t)skey * IN_W + sch * 8;
    LAS unsigned char* sdst = lds + skey * AT_PITCH + sch * 16;
#define C_GLOADK(j) do { _Pragma("unroll") for (int i_ = 0; i_ < 2; ++i_) kreg[i_] = *(const GAS u32x4*)(sbase + (size_t)(64 * (j) + 32 * i_) * IN_W + kcol); } while (0)
#define C_GLOADV(j) do { _Pragma("unroll") for (int i_ = 0; i_ < 2; ++i_) vreg[i_] = *(const GAS u32x4*)(sbase + (size_t)(64 * (j) + 32 * i_) * IN_W + vcol); } while (0)
#define C_LSTK(bi) do { _Pragma("unroll") for (int i_ = 0; i_ < 2; ++i_) *(LAS u32x4*)(sdst + (bi) * AT_TILE + i_ * 32 * AT_PITCH) = kreg[i_]; } while (0)
#define C_LSTV(bi) do { _Pragma("unroll") for (int i_ = 0; i_ < 2; ++i_) *(LAS u32x4*)(sdst + (2 + (bi)) * AT_TILE + i_ * 32 * AT_PITCH) = vreg[i_]; } while (0)
    const int koff = i16 * AT_PITCH + 16 * g;
    const int voff = 2 * AT_TILE + (4 * g + (i16 >> 2)) * AT_PITCH + (i16 & 3) * 8;
    u32x4 k1reg[2];
    C_GLOADK(0); C_GLOADV(0);
#pragma unroll
    for (int i_ = 0; i_ < 2; ++i_) k1reg[i_] = *(const GAS u32x4*)(sbase + (size_t)(64 + 32 * i_) * IN_W + kcol);
#define C_S(kb, stx) do { \
        _Pragma("unroll") for (int s_ = 0; s_ < 2; ++s_) _Pragma("unroll") for (int kt_ = 0; kt_ < 4; ++kt_) { stx[s_][kt_] = (f32x4){0.f, 0.f, 0.f, 0.f}; \
            _Pragma("unroll") for (int kk_ = 0; kk_ < 2; ++kk_) { const bf16x8 kf_ = *(const LAS bf16x8*)(lds + (kb) * AT_TILE + koff + kt_ * 16 * AT_PITCH + (2 * s_ + kk_) * 64); \
                stx[s_][kt_] = __builtin_amdgcn_mfma_f32_16x16x32_bf16(kf_, qf[2 * s_ + kk_], stx[s_][kt_], 0, 0, 0); } } \
    } while (0)
#define C_EXP(t, stx, pfo) do { \
        const float d0_ = (float)(tq - 64 * (t)); f32x4 B_[4]; \
        _Pragma("unroll") for (int kt_ = 0; kt_ < 4; ++kt_) _Pragma("unroll") for (int r_ = 0; r_ < 4; ++r_) B_[kt_][r_] = fabsf(d0_ - slo[kt_][r_]);     \
        _Pragma("unroll") for (int s_ = 0; s_ < 2; ++s_) { float ps_ = 0.f; const float nm_ = -mref[s_]; \
            _Pragma("unroll") for (int kt_ = 0; kt_ < 4; ++kt_) _Pragma("unroll") for (int r_ = 0; r_ < 4; ++r_) { const float p_ = __builtin_amdgcn_exp2f(fmaf(stx[s_][kt_][r_], c1, fmaf(-slope2, B_[kt_][r_], nm_))); stx[s_][kt_][r_] = p_; ps_ += p_; } \
            lrun[s_] += ps_; \
            _Pragma("unroll") for (int k2_ = 0; k2_ < 2; ++k2_) { u32x4 w_; w_.x = cvt_pk_bf16(stx[s_][2 * k2_][0], stx[s_][2 * k2_][1]); w_.y = cvt_pk_bf16(stx[s_][2 * k2_][2], stx[s_][2 * k2_][3]); \
                w_.z = cvt_pk_bf16(stx[s_][2 * k2_ + 1][0], stx[s_][2 * k2_ + 1][1]); w_.w = cvt_pk_bf16(stx[s_][2 * k2_ + 1][2], stx[s_][2 * k2_ + 1][3]); pfo[s_][k2_] = __builtin_bit_cast(bf16x8, w_); } } \
    } while (0)
#define C_PV(vb, pfi) do { \
        _Pragma("unroll") for (int dt_ = 0; dt_ < 8; ++dt_) _Pragma("unroll") for (int k2_ = 0; k2_ < 2; ++k2_) { \
            const s16x4 lo_ = __builtin_bit_cast(s16x4, __builtin_amdgcn_ds_read_tr16_b64_v4i16((LAS s16x4*)(lds + (vb) * AT_TILE + voff + (k2_ * 32) * AT_PITCH + dt_ * 32))); \
            const s16x4 hi_ = __builtin_bit_cast(s16x4, __builtin_amdgcn_ds_read_tr16_b64_v4i16((LAS s16x4*)(lds + (vb) * AT_TILE + voff + (k2_ * 32 + 16) * AT_PITCH + dt_ * 32))); \
            const bf16x8 vf_ = {lo_[0], lo_[1], lo_[2], lo_[3], hi_[0], hi_[1], hi_[2], hi_[3]}; \
            _Pragma("unroll") for (int s_ = 0; s_ < 2; ++s_) O[s_][dt_] = __builtin_amdgcn_mfma_f32_16x16x32_bf16(vf_, pfi[s_][k2_], O[s_][dt_], 0, 0, 0); } \
    } while (0)
    __syncthreads();
    C_LSTK(0); C_LSTV(0);
#pragma unroll
    for (int i_ = 0; i_ < 2; ++i_) *(LAS u32x4*)(sdst + 1 * AT_TILE + i_ * 32 * AT_PITCH) = k1reg[i_];
    __syncthreads();
    bf16x8 pf[2][2], pfn[2][2];
    { f32x4 st0[2][4]; C_S(0, st0); C_EXP(0, st0, pf); }
    __syncthreads();
#pragma nounroll
    for (int j = 0; j < NTC - 1; ++j) {
        const int jk = (j + 2 < NTC) ? j + 2 : NTC - 1;
        C_GLOADK(jk); C_GLOADV(j + 1);
        const LAS unsigned char* kbp = lds + ((j + 1) & 1) * AT_TILE + koff;
        const LAS unsigned char* vbp = lds + (j & 1) * AT_TILE + voff;
        f32x4 stn[2][4]; bf16x8 kfr[3][4], vfr[3][2];
#define C_LDK(kt, bi) do { _Pragma("unroll") for (int q_ = 0; q_ < 4; ++q_) kfr[bi][q_] = *(const LAS bf16x8*)(kbp + (kt) * 16 * AT_PITCH + q_ * 64); } while (0)
#define C_LDV(dt, bi) do { _Pragma("unroll") for (int k2_ = 0; k2_ < 2; ++k2_) { \
            const s16x4 lo_ = __builtin_bit_cast(s16x4, __builtin_amdgcn_ds_read_tr16_b64_v4i16((LAS s16x4*)(vbp + (k2_ * 32) * AT_PITCH + (dt) * 32))); \
            const s16x4 hi_ = __builtin_bit_cast(s16x4, __builtin_amdgcn_ds_read_tr16_b64_v4i16((LAS s16x4*)(vbp + (k2_ * 32 + 16) * AT_PITCH + (dt) * 32))); \
            vfr[bi][k2_] = (bf16x8){lo_[0], lo_[1], lo_[2], lo_[3], hi_[0], hi_[1], hi_[2], hi_[3]}; } } while (0)
        C_LDK(0, 0); C_LDK(1, 1);
#pragma unroll
        for (int kt = 0; kt < 4; ++kt) {
            __builtin_amdgcn_sched_barrier(0);
            if (kt < 2) C_LDK(kt + 2, (kt + 2) % 3); else C_LDV(kt - 2, kt - 2);
#pragma unroll
            for (int s_ = 0; s_ < 2; ++s_) { stn[s_][kt] = (f32x4){0.f, 0.f, 0.f, 0.f};
#pragma unroll
                for (int kk = 0; kk < 2; ++kk) stn[s_][kt] = __builtin_amdgcn_mfma_f32_16x16x32_bf16(kfr[kt % 3][2 * s_ + kk], qf[2 * s_ + kk], stn[s_][kt], 0, 0, 0); }
        }
        const float dq = (float)(tq - 64 * (j + 1) - 4 * g);
        float ps0 = 0.f, ps1 = 0.f; const float nm0 = -mref[0], nm1 = -mref[1];
#pragma unroll
        for (int dt = 0; dt < 8; ++dt) {
            __builtin_amdgcn_sched_barrier(0);
            if (dt < 6) C_LDV(dt + 2, (dt + 2) % 3);
#pragma unroll
            for (int k2 = 0; k2 < 2; ++k2)
#pragma unroll
                for (int s_ = 0; s_ < 2; ++s_) O[s_][dt] = __builtin_amdgcn_mfma_f32_16x16x32_bf16(vfr[dt % 3][k2], pf[s_][k2], O[s_][dt], 0, 0, 0);
#pragma unroll
            for (int rr = 0; rr < 2; ++rr) { const int kt = dt >> 1, r = 2 * (dt & 1) + rr; const float bb = -slope2 * fabsf(dq - (float)(kt * 16 + r));
                const float p0 = __builtin_amdgcn_exp2f(fmaf(stn[0][kt][r], c1, bb + nm0)), p1 = __builtin_amdgcn_exp2f(fmaf(stn[1][kt][r], c1, bb + nm1));
                stn[0][kt][r] = p0; stn[1][kt][r] = p1; ps0 += p0; ps1 += p1; }
        }
        __builtin_amdgcn_sched_barrier(0);
#undef C_LDK
#undef C_LDV
        lrun[0] += ps0; lrun[1] += ps1;
#pragma unroll
        for (int s_ = 0; s_ < 2; ++s_)
#pragma unroll
            for (int k2 = 0; k2 < 2; ++k2) { u32x4 w_; w_.x = cvt_pk_bf16(stn[s_][2 * k2][0], stn[s_][2 * k2][1]); w_.y = cvt_pk_bf16(stn[s_][2 * k2][2], stn[s_][2 * k2][3]);
                w_.z = cvt_pk_bf16(stn[s_][2 * k2 + 1][0], stn[s_][2 * k2 + 1][1]); w_.w = cvt_pk_bf16(stn[s_][2 * k2 + 1][2], stn[s_][2 * k2 + 1][3]); pfn[s_][k2] = __builtin_bit_cast(bf16x8, w_); }
        C_LSTK(j & 1); C_LSTV((j + 1) & 1);
        __syncthreads();
#pragma unroll
        for (int s = 0; s < 2; ++s)
#pragma unroll
            for (int k2 = 0; k2 < 2; ++k2) pf[s][k2] = pfn[s][k2];
    }
    C_PV((NTC - 1) & 1, pf);
#undef C_GLOADK
#undef C_GLOADV
#undef C_LSTK
#undef C_LSTV
#undef C_S
#undef C_EXP
#undef C_PV
    float inv[2];
#pragma unroll
    for (int s = 0; s < 2; ++s) { float l = lrun[s]; l += __shfl_xor(l, 16); l += __shfl_xor(l, 32); inv[s] = 1.0f / l; }
    const int orow_r = b * T + tq, ocol = MIX_C + h * 128 + 4 * g;
    float ss = 0.f;
#pragma unroll
    for (int dt = 0; dt < 8; ++dt) { O[0][dt] = O[0][dt] * inv[0] - (O[1][dt] * inv[1]) * lam; const f32x4 o = O[0][dt]; ss += (o[0] * o[0] + o[1] * o[1]) + (o[2] * o[2] + o[3] * o[3]); }
    ss += __shfl_xor(ss, 16); ss += __shfl_xor(ss, 32);
    const float rs = rsqrtf(ss * (1.0f / 128.0f) + SUBLN_EPS) * outscale;
#pragma unroll
    for (int dt = 0; dt < 8; ++dt) { const f32x4 gv = *(const GAS f32x4*)(subg + 16 * dt + 4 * g); const f32x4 o = O[0][dt] * rs * gv;
        u32x2 w; w.x = cvt_pk_bf16(o[0], o[1]); w.y = cvt_pk_bf16(o[2], o[3]); *(GAS u32x2*)((guc*)mix + pg8::atile_off(orow_r, ocol + 16 * dt, D / 64)) = w; }
}

__device__ __forceinline__ void transpose_item(const gfl* __restrict__ W, int N, int k0, int n0, guc* __restrict__ dimg, int r0, int nkt, LAS float* scr, int lane) {
#pragma unroll 8
    for (int i = 0; i < 32; ++i) { const int kk = 2 * i + (lane >> 5); scr[kk * 33 + (lane & 31)] = W[(size_t)(k0 + kk) * N + n0 + (lane & 31)]; }
    LDS_WAIT(); asm volatile("" ::: "memory");
    const int c = lane & 7;
#pragma unroll
    for (int j = 0; j < 4; ++j) { const int n = (lane >> 3) + 8 * j; const LAS float* s = scr + (8 * c) * 33 + n;
        u32x4 o; o.x = cvt_pk_bf16(s[0 * 33], s[1 * 33]); o.y = cvt_pk_bf16(s[2 * 33], s[3 * 33]); o.z = cvt_pk_bf16(s[4 * 33], s[5 * 33]); o.w = cvt_pk_bf16(s[6 * 33], s[7 * 33]);
        *(GAS u32x4*)(dimg + pg8::btile_off(r0 + n, k0 >> 6, c, nkt)) = o; }
    LDS_WAIT(); asm volatile("" ::: "memory");
}

__device__ __forceinline__ void acc8(float (&s)[8], u32x4 w, float sg) {
    asm volatile("" : "+v"(w));
    s[0] += sg * bf_lo(w.x); s[1] += sg * bf_hi(w.x); s[2] += sg * bf_lo(w.y); s[3] += sg * bf_hi(w.y); s[4] += sg * bf_lo(w.z); s[5] += sg * bf_hi(w.z); s[6] += sg * bf_lo(w.w); s[7] += sg * bf_hi(w.w);
}
template <int R>
__device__ __forceinline__ void stencil_block(const gbf* __restrict__ up, int t0, guc* __restrict__ zimg, int m0, int ch) {
    guc* zlo = zimg + pg8::atile_off(m0, ch * 8, POOLW / 64); guc* zhi = zimg + pg8::atile_off(m0 + 8, ch * 8, POOLW / 64);
    u32x4 wv[16 + 2 * R];
#pragma unroll
    for (int k = 0; k < 16 + 2 * R; ++k) { const int q = t0 - R + k; const bool ok = (q >= 0) && (q < T); wv[k] = *(const GAS u32x4*)(up + (size_t)(ok ? q : t0) * IN_W); }
    __builtin_amdgcn_sched_barrier(0);
#pragma unroll
    for (int k = 0; k < 16 + 2 * R; ++k) { const int q = t0 - R + k; const bool ok = (q >= 0) && (q < T); if (!ok) wv[k] = (u32x4){0u, 0u, 0u, 0u}; }
    float s[8];
#pragma unroll
    for (int j = 0; j < 8; ++j) s[j] = 0.f;
#pragma unroll
    for (int k = 0; k < 2 * R + 1; ++k) acc8(s, wv[k], 1.0f);
#pragma unroll
    for (int i = 0; i < 16; ++i) {
        const int t = t0 + i, tlo = (t - R < 0) ? 0 : t - R, thi = (t + R + 1 > T) ? T : t + R + 1; const float ic = __builtin_amdgcn_rcpf((float)(thi - tlo));
        u32x4 w = wv[R + i]; asm volatile("" : "+v"(w));
        u32x4 o; o.x = cvt_pk_bf16(s[0] * ic - bf_lo(w.x), s[1] * ic - bf_hi(w.x)); o.y = cvt_pk_bf16(s[2] * ic - bf_lo(w.y), s[3] * ic - bf_hi(w.y));
        o.z = cvt_pk_bf16(s[4] * ic - bf_lo(w.z), s[5] * ic - bf_hi(w.z)); o.w = cvt_pk_bf16(s[6] * ic - bf_lo(w.w), s[7] * ic - bf_hi(w.w));
        *(GAS u32x4*)((i < 8 ? zlo : zhi) + (i & 7) * 64) = o;
        if (i < 15) { acc8(s, wv[i + 2 * R + 1], 1.0f); acc8(s, wv[i], -1.0f); }
    }
}

struct Args { const float* in[21]; float* out; unsigned char* ws; int ph_lo, ph_hi; };
enum { I_X = 0, I_C, I_ADAW, I_ADAB, I_MPRE, I_MPOST, I_WIN, I_SINK, I_POOLW, I_PSCALE, I_LAMBDA, I_SUBG, I_WGATE, I_BGATE, I_WBRANCH, I_WOUT, I_FPRE, I_FPOST, I_FWG, I_FWU, I_FWD };

template <bool SRC_BF, bool DST_BF>
__device__ __forceinline__ void rownorm_phase(const void GAS* xsrc_, void GAS* xdst_, const gbf* y, const gfl* gpost, const gfl* gate,
                                              const gfl* gpre, const gfl* shift, const gfl* scale, gbf* hdst, int bx, int G, LAS unsigned char* lds) {
    const int tid = fresh_tid(), lane = tid & 63, wave = __builtin_amdgcn_readfirstlane(tid >> 6);
    const bool al = (G & 7) == 0;
    const int b0 = al ? (bx & 7) : 0, bstep = al ? 8 : 1, cb = al ? (bx >> 3) : bx, nb = al ? (G >> 3) : G;
    LAS float* pa = (LAS float*)lds; LAS float* pb = pa + D; LAS float* pc = pb + D;
    for (int b = b0; b < BATCH; b += bstep) {
        __syncthreads();
        { const int c0 = tid * 8;
#pragma unroll
          for (int q = 0; q < 2; ++q) { const int c = c0 + 4 * q;
            if (y) { const f32x4 g = *(const GAS f32x4*)(gate + (size_t)b * ADA + c), p = *(const GAS f32x4*)(gpost + c); *(LAS f32x4*)(pa + c) = g * p; }
            if (hdst) { const f32x4 p = *(const GAS f32x4*)(gpre + c), sc = *(const GAS f32x4*)(scale + (size_t)b * ADA + c), sh = *(const GAS f32x4*)(shift + (size_t)b * ADA + c);
                *(LAS f32x4*)(pb + c) = p * (1.0f + sc); *(LAS f32x4*)(pc + c) = sh; } } }
        __syncthreads();
        constexpr int NR = SRC_BF ? 2 : 1;
        constexpr int QS = 8;
        for (int r = cb * 8 * NR + wave; r < T; r += NR * nb * 8) {
            u32x2 xw[NR][16], yw[NR][16]; f32x4 xf[SRC_BF ? 1 : 16];
#pragma unroll
            for (int q = 0; q < NR; ++q) { const int rq = (r + q * QS < T) ? r + q * QS : r; const int m = b * T + rq; const size_t ro = (size_t)m * D + 4 * lane;
                if constexpr (SRC_BF) {
#pragma unroll
                    for (int j = 0; j < 16; ++j) xw[q][j] = *(const GAS u32x2*)((const gbf*)xsrc_ + ro + 256 * j);
                } else {
#pragma unroll
                    for (int j = 0; j < 16; ++j) xf[j] = *(const GAS f32x4*)((const gfl*)xsrc_ + ro + 256 * j);
                }
                if (y) {
#pragma unroll
                    for (int j = 0; j < 16; ++j) yw[q][j] = *(const GAS u32x2*)((const guc*)y + pg8::atile_off(m, 4 * lane + 256 * j, D / 64));
                } }
#pragma unroll
            for (int q = 0; q < NR; ++q) {
                if (r + q * QS >= T) break;
                const int m = b * T + r + q * QS; const size_t ro = (size_t)m * D + 4 * lane;
                f32x4 xv[16];
#pragma unroll
                for (int j = 0; j < 16; ++j) { if constexpr (SRC_BF) xv[j] = (f32x4){bf_lo(xw[q][j].x), bf_hi(xw[q][j].x), bf_lo(xw[q][j].y), bf_hi(xw[q][j].y)}; else xv[j] = xf[j]; }
                if (y) {
                    float ss = 0.f;
#pragma unroll
                    for (int j = 0; j < 16; ++j) { const f32x4 yv = {bf_lo(yw[q][j].x), bf_hi(yw[q][j].x), bf_lo(yw[q][j].y), bf_hi(yw[q][j].y)}; ss += (yv[0] * yv[0] + yv[1] * yv[1]) + (yv[2] * yv[2] + yv[3] * yv[3]); }
                    const float rstd = rsqrtf(wave_sum(ss) * (1.0f / D) + NORM_EPS);
#pragma unroll
                    for (int j = 0; j < 16; ++j) { const f32x4 av = *(const LAS f32x4*)(pa + 4 * lane + 256 * j);
                        const f32x4 yv = {bf_lo(yw[q][j].x), bf_hi(yw[q][j].x), bf_lo(yw[q][j].y), bf_hi(yw[q][j].y)};
                        xv[j] += av * (yv * rstd);
                        if constexpr (DST_BF) { u32x2 w; w.x = cvt_pk_bf16(xv[j][0], xv[j][1]); w.y = cvt_pk_bf16(xv[j][2], xv[j][3]); *(GAS u32x2*)((gbf*)xdst_ + ro + 256 * j) = w;
                            xv[j] = (f32x4){bf_lo(w.x), bf_hi(w.x), bf_lo(w.y), bf_hi(w.y)}; }
                        else *(GAS f32x4*)((gfl*)xdst_ + ro + 256 * j) = xv[j];
                        if ((j & 3) == 3) asm volatile("" ::: "memory"); }
                }
                if (hdst) {
                    float ss = 0.f;
#pragma unroll
                    for (int j = 0; j < 16; ++j) ss += (xv[j][0] * xv[j][0] + xv[j][1] * xv[j][1]) + (xv[j][2] * xv[j][2] + xv[j][3] * xv[j][3]);
                    const float rstd = rsqrtf(wave_sum(ss) * (1.0f / D) + NORM_EPS);
#pragma unroll
                    for (int j = 0; j < 16; ++j) { const f32x4 bv = *(const LAS f32x4*)(pb + 4 * lane + 256 * j), cv = *(const LAS f32x4*)(pc + 4 * lane + 256 * j);
                        const f32x4 hv = (xv[j] * rstd) * bv + cv; u32x2 w; w.x = cvt_pk_bf16(hv[0], hv[1]); w.y = cvt_pk_bf16(hv[2], hv[3]); *(GAS u32x2*)((guc*)hdst + pg8::atile_off(m, 4 * lane + 256 * j, D / 64)) = w;
                        if ((j & 3) == 3) asm volatile("" ::: "memory"); }
                }
            }
        }
    }
    __syncthreads();
}

__global__ void __launch_bounds__(512, 2) fwd(Args a) {
    extern __shared__ __attribute__((aligned(16))) unsigned char lds_raw[];
    LAS unsigned char* lds = (LAS unsigned char*)lds_raw;
    unsigned* ctl = (unsigned*)(a.ws + WS_CTL);
    volatile LAS unsigned* MISC = (volatile LAS unsigned*)(lds + MISC_OFF);
    for (int u = threadIdx.x; u < (LDS_BYTES - LDSCTL_OFF) / 4; u += 512) ((LAS unsigned*)(lds + LDSCTL_OFF))[u] = 0u;
    __syncthreads();
    const int lo = a.ph_lo, hi = a.ph_hi;
    XcdBarrier bar; bar.bar = ctl + CW_BAR; bar.x = 0; bar.st = nullptr;
    if (hi - lo > 1) bar = xcd_barrier_post(ctl + CW_BAR, MISC + 8);
#define IN(k) (lo <= (k) && (k) < hi)
#define SEAM(k) do { if (IN(k) && IN((k) + 1)) xcd_barrier(bar); } while (0)
#define INP(k) ((const gfl*)a.in[opq(k)])
#define WSB ((guc*)opqp(a.ws))
#define MODP ((gfl*)(WSB + WS_MOD))
#define HB ((gbf*)(WSB + WS_H))
#define MIXP ((gbf*)(WSB + WS_MIX))
#define MERGP ((gbf*)(WSB + WS_MERG))
#define YB ((gbf*)(WSB + WS_Y))
#define XBP ((gbf*)(WSB + WS_M32))
#define ZB ((gbf*)(WSB + WS_Z))
#define PROJP ((gbf*)(WSB + WS_PROJ))
#define GATESP ((gbf*)(WSB + WS_GATES))
#define HIDP ((gbf*)(WSB + WS_HID))
#define WLAYER(l) (WSB + WS_W + (size_t)(l) * W_LAYER)
#define GEOM() const int G = opq((int)gridDim.x), bx = opq((int)blockIdx.x), vcu = (G % 8 == 0) ? (bx % 8) * (G / 8) + bx / 8 : bx; (void)vcu

    if (IN(0)) {
        GEOM();
        {
            LAS float* cond = (LAS float*)lds;
            const int tid = fresh_tid();
            const int cq = tid % 24, kg = tid / 24;
            const gfl* cin = INP(I_C); const gfl* adaw = INP(I_ADAW); const gfl* adab = INP(I_ADAB); gfl* mod = MODP;
            for (int slab = vcu; slab < DEPTH * ADA / 96; slab += G) {
                const int l = slab / (ADA / 96), col0 = (slab % (ADA / 96)) * 96;
                for (int i = tid; i < BATCH * D; i += 512) { const int b = i / D, k = i % D; const float v = cin[i]; cond[k * 8 + b] = v / (1.0f + __expf(-v)); }
                __syncthreads();
                float acc[8][4];
#pragma unroll
                for (int b = 0; b < 8; ++b)
#pragma unroll
                    for (int j = 0; j < 4; ++j) acc[b][j] = 0.f;
                if (kg < 21) {
                    const gfl* wp = adaw + (size_t)l * D * ADA + col0 + cq * 4;
#pragma unroll 4
                    for (int k = kg; k < D; k += 21) {
                        const f32x4 w = *(const GAS f32x4*)(wp + (size_t)k * ADA);
                        const f32x4 c0 = *(const LAS f32x4*)(cond + k * 8), c1 = *(const LAS f32x4*)(cond + k * 8 + 4);
#pragma unroll
                        for (int j = 0; j < 4; ++j) { acc[0][j] += c0[0] * w[j]; acc[1][j] += c0[1] * w[j]; acc[2][j] += c0[2] * w[j]; acc[3][j] += c0[3] * w[j];
                            acc[4][j] += c1[0] * w[j]; acc[5][j] += c1[1] * w[j]; acc[6][j] += c1[2] * w[j]; acc[7][j] += c1[3] * w[j]; }
                    }
                }
                __syncthreads();
                LAS float* part = (LAS float*)lds;
                if (kg < 21) {
#pragma unroll
                    for (int b = 0; b < 8; ++b) *(LAS f32x4*)(part + (kg * 8 + b) * 96 + cq * 4) = (f32x4){acc[b][0], acc[b][1], acc[b][2], acc[b][3]};
                }
                __syncthreads();
                for (int o = tid; o < 8 * 96; o += 512) { const int b = o / 96, cc = o % 96; float s = adab[(size_t)l * ADA + col0 + cc];
                    for (int q = 0; q < 21; ++q) s += part[(q * 8 + b) * 96 + cc];
                    mod[((size_t)l * BATCH + b) * ADA + col0 + cc] = s; }
                __syncthreads();
            }
        }
        {
            const int tid = fresh_tid(), lane = tid & 63, wave = __builtin_amdgcn_readfirstlane(tid >> 6), gw = vcu * 8 + wave, ngw = G * 8;
            LAS float* scr = (LAS float*)(lds + wave * 8448);
            constexpr int I_IN = 64 * (IN_W / 32), I_GT = 64 * (GATE_W / 32), I_BR = 64 * (D / 32), I_OUT = I_BR, I_FG = 64 * (FF / 32), I_FU = I_FG, I_FD = (FF / 64) * (D / 32), I_PW = 4 * 4 * 8;
            constexpr int PER_LAYER = I_IN + I_GT + I_BR + I_OUT + I_FG + I_FU + I_FD + I_PW;
            for (int it = gw; it < DEPTH * PER_LAYER; it += ngw) {
                const int l = it / PER_LAYER; int r = it - l * PER_LAYER;
                guc* wl = WLAYER(l);
                if (r < I_IN) { const int nb = r % (IN_W / 32), kb = r / (IN_W / 32);
                    transpose_item(INP(I_WIN) + (size_t)l * D * IN_W, IN_W, kb * 64, nb * 32, wl + W_1, nb * 32, D / 64, scr, lane); continue; } r -= I_IN;
                if (r < I_GT) { const int nb = r % (GATE_W / 32), kb = r / (GATE_W / 32);
                    transpose_item(INP(I_WGATE) + (size_t)l * D * GATE_W, GATE_W, kb * 64, nb * 32, wl + W_1, IN_W + nb * 32, D / 64, scr, lane); continue; } r -= I_GT;
                if (r < I_BR) { const int nb = r % (D / 32), kb = r / (D / 32);
                    transpose_item(INP(I_WBRANCH) + (size_t)l * D * D, D, kb * 64, nb * 32, wl + W_B, nb * 32, D / 64, scr, lane); continue; } r -= I_BR;
                if (r < I_OUT) { const int nb = r % (D / 32), kb = r / (D / 32);
                    transpose_item(INP(I_WOUT) + (size_t)l * D * D, D, kb * 64, nb * 32, wl + W_O, nb * 32, D / 64, scr, lane); continue; } r -= I_OUT;
                if (r < I_FG) { const int nb = r % (FF / 32), kb = r / (FF / 32); const int n0 = nb * 32, row = (n0 / 128) * 256 + (n0 % 128);
                    transpose_item(INP(I_FWG) + (size_t)l * D * FF, FF, kb * 64, n0, wl + W_F, row, D / 64, scr, lane); continue; } r -= I_FG;
                if (r < I_FU) { const int nb = r % (FF / 32), kb = r / (FF / 32); const int n0 = nb * 32, row = (n0 / 128) * 256 + 128 + (n0 % 128);
                    transpose_item(INP(I_FWU) + (size_t)l * D * FF, FF, kb * 64, n0, wl + W_F, row, D / 64, scr, lane); continue; } r -= I_FU;
                if (r < I_FD) { const int nb = r % (D / 32), kb = r / (D / 32);
                    transpose_item(INP(I_FWD) + (size_t)l * FF * D, D, kb * 64, nb * 32, wl + W_D, nb * 32, FF / 64, scr, lane); continue; } r -= I_FD;
                { const int gi = r / 32, rr = r % 32, nb = rr % 8, kb = rr / 8;
                    transpose_item(INP(I_POOLW) + ((size_t)l * 4 + gi) * 256 * 256, 256, kb * 64, nb * 32, WSB + WS_PWT + (size_t)l * 1024 * 256 * 2, gi * 256 + nb * 32, 4, scr, lane); }
            }
        }
    }
    SEAM(0);
    if (IN(1)) { GEOM(); const gfl* mod = MODP; rownorm_phase<false, true>(INP(I_X), (void GAS*)nullptr, (const gbf*)nullptr, (const gfl*)nullptr, (const gfl*)nullptr, INP(I_MPRE), mod + 0 * D, mod + 1 * D, HB, bx, G, lds); }
    SEAM(1);

#pragma nounroll
    for (int l = 0; l < DEPTH; ++l) {
        const int pb = 2 + 9 * l;
        if (IN(pb + 0)) {
            GEOM();
            typedef pg8::Prob<1, 0, 0, D / 64, 0, 0> PT; PT P{HB, (const gbf*)(WLAYER(l) + W_1), D / 64, D / 64, M / 256, N1 / 256, G, bx, 0, 0};
            pg8::EpiInGate E{PROJP, GATESP, INP(I_BGATE) + (size_t)l * GATE_W, (GAS unsigned*)(WSB + WS_CTL) + CW_NMAX + l * 1024};
            pg8::gemm_phase<pg8::EpiInGate, PT, true, true>(lds, P, E);
        }
        SEAM(pb + 0);
        const bool zlocal = (opq((int)gridDim.x) == (M / 256) * 4);
        if (IN(pb + 1) && !zlocal) {
            GEOM();
            const int tid = fresh_tid(); const gbf* proj = PROJP; gbf* zb = ZB;
            for (int it = (vcu * 512 + tid); it < M * 128; it += G * 512) {
                const int m = it >> 7, ch = it & 127, t = m % T, r = 1 << (ch >> 5);
                const int tlo = (t - r < 0) ? 0 : t - r, thi = (t + r + 1 > T) ? T : t + r + 1;
                const gbf* up = proj + (size_t)(m - t) * IN_W + OFF_U + ch * 8;
                float s[8];
#pragma unroll
                for (int j = 0; j < 8; ++j) s[j] = 0.f;
                u32x4 wv[17];
#pragma unroll
                for (int k = 0; k < 17; ++k) { const int q = t - 8 + k; const bool ok = (q >= tlo) && (q < thi); wv[k] = ok ? *(const GAS u32x4*)(up + (size_t)(ok ? q : t) * IN_W) : (u32x4){0u, 0u, 0u, 0u}; }
#pragma unroll
                for (int k = 0; k < 17; ++k) { const u32x4 w = wv[k];
                    s[0] += bf_lo(w.x); s[1] += bf_hi(w.x); s[2] += bf_lo(w.y); s[3] += bf_hi(w.y); s[4] += bf_lo(w.z); s[5] += bf_hi(w.z); s[6] += bf_lo(w.w); s[7] += bf_hi(w.w); }
                const u32x4 w = *(const GAS u32x4*)(up + (size_t)t * IN_W); const float ic = 1.0f / (float)(thi - tlo);
                u32x4 o; o.x = cvt_pk_bf16(s[0] * ic - bf_lo(w.x), s[1] * ic - bf_hi(w.x)); o.y = cvt_pk_bf16(s[2] * ic - bf_lo(w.y), s[3] * ic - bf_hi(w.y));
                o.z = cvt_pk_bf16(s[4] * ic - bf_lo(w.z), s[5] * ic - bf_hi(w.z)); o.w = cvt_pk_bf16(s[6] * ic - bf_lo(w.w), s[7] * ic - bf_hi(w.w));
                *(GAS u32x4*)((guc*)zb + pg8::atile_off(m, ch * 8, POOLW / 64)) = o;
            }
        }
        if (!zlocal) SEAM(pb + 1);
        if (IN(pb + 2)) {
            const float lam_init = (l == 0) ? 0.2f : (0.8f - 0.6f * 0.7408182206817179f);
            {
                GEOM();
                typedef pg8::Prob<1, 0, 0, 4, 0, 0> PT; PT P{ZB, (const gbf*)(WSB + WS_PWT) + (size_t)l * 1024 * 256, POOLW / 64, 4, M / 256, 4, G, bx, 256, 0};
                if (zlocal) {
                    pg8::Unit u0;
                    if (P.next(0, u0)) { const int tid = fresh_tid(), m0 = u0.pm * 256 + (tid >> 5) * 16, t0 = m0 % T, ch = u0.pn * 32 + (tid & 31);
                        const gbf* up = PROJP + (size_t)(m0 - t0) * IN_W + OFF_U + ch * 8; guc* zimg = (guc*)ZB;
                        if (u0.pn == 0) stencil_block<1>(up, t0, zimg, m0, ch); else if (u0.pn == 1) stencil_block<2>(up, t0, zimg, m0, ch);
                        else if (u0.pn == 2) stencil_block<4>(up, t0, zimg, m0, ch); else stencil_block<8>(up, t0, zimg, m0, ch); }
                    __syncthreads();
                }
                pg8::EpiPool E{MIXP, INP(I_PSCALE) + (size_t)l * POOLW};
                pg8::gemm_phase<pg8::EpiPool, PT, false, true>(lds, P, E);
            }
            {
                GEOM(); const gbf* proj = PROJP; gbf* mix = MIXP; const gfl* sinkp = INP(I_SINK) + l * 12;
                for (int u = vcu; u < BATCH * 12 * 16; u += G) {
                    const int qb = u & 15, hh = (u >> 4) % 12, b = u / (16 * 12);
                    const float slope2 = exp2f(-8.0f * (float)(hh + 1) / 12.0f) * LOG2E, sink2 = sinkp[hh] * LOG2E;
                    attn_unit<1>(lds, proj, mix, b, hh, qb, slope2, sink2, 0.f, (const gfl*)nullptr, 1.f);
                }
            }
            {
                GEOM(); const gbf* proj = PROJP; gbf* mix = MIXP; const gfl* subg = INP(I_SUBG) + (size_t)l * 128;
                const gfl* lv = INP(I_LAMBDA) + (size_t)l * 256; const int lane = fresh_tid() & 63;
                const float s1 = wave_sum(lv[lane] * lv[64 + lane]), s2 = wave_sum(lv[128 + lane] * lv[192 + lane]);
                const float lam = __expf(s1) - __expf(s2) + lam_init;
                for (int u = vcu; u < BATCH * 12 * 16; u += G) {
                    const int qb = u & 15, hh = (u >> 4) % 12, b = u / (16 * 12);
                    const float slope2 = exp2f(-8.0f * (float)(hh + 1) / 12.0f) * LOG2E;
                    const GAS unsigned* nm = (const GAS unsigned*)(WSB + WS_CTL) + CW_NMAX + l * 1024 + b * 48 + hh * 4;
                    const float q0 = 1.01f * (__uint_as_float(nm[0]) + __uint_as_float(nm[1])), q1 = 1.01f * (__uint_as_float(nm[2]) + __uint_as_float(nm[3]));
                    const float k0 = 1.01f * (__uint_as_float(nm[BATCH * 48]) + __uint_as_float(nm[BATCH * 48 + 1])), k1 = 1.01f * (__uint_as_float(nm[BATCH * 48 + 2]) + __uint_as_float(nm[BATCH * 48 + 3]));
                    const float bound = 0.125f * LOG2E * sqrtf(fmaxf(q0 * k0, q1 * k1));
                    if (bound <= 60.0f) attn_c_fast(lds, proj, mix, b, hh, qb, slope2, lam, subg, 1.0f - lam_init, k0, k1);
                    else attn_unit<2>(lds, proj, mix, b, hh, qb, slope2, 0.f, lam, subg, 1.0f - lam_init);
                }
            }
        }
        SEAM(pb + 2);
        if (IN(pb + 3)) {
            GEOM();
            typedef pg8::Prob<3, MIX_B, MIX_C, 1536 / 64, 1024 / 64, 1536 / 64> PT; PT P{MIXP, (const gbf*)(WLAYER(l) + W_B), D / 64, D / 64, M / 256, D / 256, G, bx, 0, 1};
            pg8::EpiBranch E{GATESP, MERGP};
            pg8::gemm_phase<pg8::EpiBranch, PT, true, true>(lds, P, E);
        }
        SEAM(pb + 3);
        if (IN(pb + 4)) {
            GEOM();
            typedef pg8::Prob<1, 0, 0, D / 64, 0, 0> PT; PT P{MERGP, (const gbf*)(WLAYER(l) + W_O), D / 64, D / 64, M / 256, D / 256, G, bx, 0, 0};
            pg8::EpiStore E{YB, D};
            pg8::gemm_phase<pg8::EpiStore, PT, true, true>(lds, P, E);
        }
        SEAM(pb + 4);
        if (IN(pb + 5)) { GEOM(); const gfl* modl = MODP + (size_t)l * BATCH * ADA;
            if (l == 0) rownorm_phase<false, true>(INP(I_X), XBP, YB, INP(I_MPOST) + (size_t)l * D, modl + 2 * D, INP(I_FPRE) + (size_t)l * D, modl + 3 * D, modl + 4 * D, HB, bx, G, lds);
            else rownorm_phase<true, true>(XBP, XBP, YB, INP(I_MPOST) + (size_t)l * D, modl + 2 * D, INP(I_FPRE) + (size_t)l * D, modl + 3 * D, modl + 4 * D, HB, bx, G, lds); }
        SEAM(pb + 5);
        if (IN(pb + 6)) {
            GEOM();
            typedef pg8::Prob<1, 0, 0, D / 64, 0, 0> PT; PT P{HB, (const gbf*)(WLAYER(l) + W_F), D / 64, D / 64, M / 256, NF / 256, G, bx, 0, 0};
            pg8::EpiSwiglu E{HIDP};
            pg8::gemm_phase<pg8::EpiSwiglu, PT, true, true>(lds, P, E);
        }
        SEAM(pb + 6);
        if (IN(pb + 7)) {
            GEOM();
            typedef pg8::Prob<1, 0, 0, FF / 64, 0, 0> PT; PT P{HIDP, (const gbf*)(WLAYER(l) + W_D), FF / 64, FF / 64, M / 256, D / 256, G, bx, 0, 0};
            pg8::EpiStore E{YB, D};
            pg8::gemm_phase<pg8::EpiStore, PT, true, true>(lds, P, E);
        }
        SEAM(pb + 7);
        if (IN(pb + 8)) {
            GEOM(); const gfl* modl = MODP + (size_t)l * BATCH * ADA;
            const bool more = (l + 1 < DEPTH); const int ln = more ? l + 1 : l; const gfl* modn = MODP + (size_t)ln * BATCH * ADA;
            if (more) rownorm_phase<true, true>(XBP, XBP, YB, INP(I_FPOST) + (size_t)l * D, modl + 5 * D, INP(I_MPRE) + (size_t)ln * D, modn + 0 * D, modn + 1 * D, HB, bx, G, lds);
            else rownorm_phase<true, false>(XBP, (gfl*)a.out, YB, INP(I_FPOST) + (size_t)l * D, modl + 5 * D, INP(I_MPRE) + (size_t)ln * D, modn + 0 * D, modn + 1 * D, (gbf*)nullptr, bx, G, lds);
        }
        SEAM(pb + 8);
    }
#undef IN
#undef SEAM
}


constexpr int N_PHASES = 2 + 9 * DEPTH;
extern "C" void kernel_launch(void* const* d_in, const int* in_sizes, int n_in, void* d_out, int out_size, void* d_ws, size_t ws_size, hipStream_t stream) {
    static int grid = 0;
    if (grid == 0) {
        if (n_in != 21 || in_sizes[0] != M * D || out_size != M * D || ws_size < WS_END) { fprintf(stderr, "kernel_launch: unexpected shapes (n_in %d, in0 %d, out %d, ws %zu < %zu)\n", n_in, n_in > 0 ? in_sizes[0] : -1, out_size, ws_size, (size_t)WS_END); grid = -1; return; }
        int dev = 0, cus = 0, per_cu = 0;
        if (hipGetDevice(&dev) != hipSuccess || hipDeviceGetAttribute(&cus, hipDeviceAttributeMultiprocessorCount, dev) != hipSuccess) { grid = -1; return; }
        if (hipFuncSetAttribute((const void*)fwd, hipFuncAttributeMaxDynamicSharedMemorySize, LDS_BYTES) != hipSuccess) { fprintf(stderr, "kernel_launch: hipFuncSetAttribute failed\n"); grid = -1; return; }
        if (hipOccupancyMaxActiveBlocksPerMultiprocessor(&per_cu, (const void*)fwd, 512, LDS_BYTES) != hipSuccess || per_cu < 1) fprintf(stderr, "kernel_launch: occupancy query reports %d\n", per_cu);
        (void)hipGetLastError();
        grid = cus;
    }
    if (grid < 0) return;
    if (hipMemsetAsync((char*)d_ws + WS_CTL, 0, CTL_ZERO_BYTES, stream) != hipSuccess) return;
    Args a{};
    for (int i = 0; i < 21; ++i) a.in[i] = (const float*)d_in[i];
    a.out = (float*)d_out; a.ws = (unsigned char*)d_ws;
#if MK_N_LAUNCHES == 1
    a.ph_lo = 0; a.ph_hi = N_PHASES;
    hipLaunchKernelGGL(fwd, dim3(grid), dim3(512), LDS_BYTES, stream, a);
#else
    for (int p = 0; p < N_PHASES; ++p) { a.ph_lo = p; a.ph_hi = p + 1; hipLaunchKernelGGL(fwd, dim3(grid), dim3(512), LDS_BYTES, stream, a); }
#endif
}
```
